# Optimizing an MI355X kernel written in HIP

```python
import jax, jax.numpy as jnp
from jax import lax
import numpy as np

D_MODEL = 2048
BATCH = 4
SEQ = 4096
DEPTH = 2
DEC_BATCH = 8
DEC_SEQ = 4096
PAST_LEN = 128

D_FF = 5632
N_AB_LAYERS = (DEPTH + 1) // 2
N_C_LAYERS = DEPTH // 2
MLA_HEADS = 8
Q_LORA = 512
KV_LORA = 512
QK_NOPE = 128
QK_ROPE = 64
QK_HEAD = QK_NOPE + QK_ROPE
V_HEAD = 128
MLA_WIDTH = MLA_HEADS * V_HEAD
CONV_WIDTH = D_MODEL - MLA_WIDTH
CONV_K = 3
AB_IN = Q_LORA + KV_LORA + QK_ROPE + 3 * CONV_WIDTH
AB_SPLITS = [Q_LORA, Q_LORA + KV_LORA, Q_LORA + KV_LORA + QK_ROPE,
             Q_LORA + KV_LORA + QK_ROPE + CONV_WIDTH,
             Q_LORA + KV_LORA + QK_ROPE + 2 * CONV_WIDTH]
C_HEADS = 16
C_KV_HEADS = 4
C_GROUP = C_HEADS // C_KV_HEADS
C_HEAD_DIM = 128
C_IN = (C_HEADS + 2 * C_KV_HEADS) * C_HEAD_DIM
WINDOW = 128
BLOCK = 128
ROPE_THETA = 10000.0
EPS = 1e-6
NEG = -1e30

kernel_name = "hybrid_mla_shortconv_swa_macaron_encoder"


def rms_norm(x, g):
    xf = x.astype(jnp.float32)
    y = xf * lax.rsqrt(jnp.mean(xf * xf, axis=-1, keepdims=True) + EPS)
    return (y * g.astype(jnp.float32)).astype(x.dtype)


def rope_tables(seq_len, dim):
    inv = 1.0 / (ROPE_THETA ** (jnp.arange(0, dim, 2, dtype=jnp.float32) / dim))
    ang = jnp.arange(seq_len, dtype=jnp.float32)[:, None] * inv[None, :]
    return jnp.cos(ang), jnp.sin(ang)


def apply_rope(x, cos, sin):
    half = x.shape[-1] // 2
    xf = x.astype(jnp.float32)
    x1, x2 = xf[..., :half], xf[..., half:]
    c, s = cos[:, None, :], sin[:, None, :]
    return jnp.concatenate([x1 * c - x2 * s, x2 * c + x1 * s], axis=-1).astype(x.dtype)


def swiglu(x, w_gate, w_up, w_down):
    return (jax.nn.silu(x @ w_gate) * (x @ w_up)) @ w_down


def dense_attention(q, k, v, scale):
    bsz, s_len, h, dq = q.shape
    nb = s_len // BLOCK
    q_blocks = q.reshape(bsz, nb, BLOCK, h, dq).transpose(1, 0, 2, 3, 4)

    def one_block(qb):
        s = jnp.einsum('bqhd,bkhd->bhqk', qb, k).astype(jnp.float32) * scale
        p = jax.nn.softmax(s, axis=-1).astype(v.dtype)
        return jnp.einsum('bhqk,bkhd->bqhd', p, v)

    out = lax.map(one_block, q_blocks)
    return out.transpose(1, 0, 2, 3, 4).reshape(bsz, s_len, h, v.shape[-1])


def mla_conv_mixer(h, w_in, q_a_norm, w_q_b, kv_a_norm, w_kv_b, q_norm, k_norm, conv_w, w_out):
    bsz, s_len, _ = h.shape
    z = h @ w_in
    q_a, kv_a, k_rope, gate_b, gate_c, u = jnp.split(z, AB_SPLITS, axis=-1)
    q = (rms_norm(q_a, q_a_norm) @ w_q_b).reshape(bsz, s_len, MLA_HEADS, QK_HEAD)
    kv = (rms_norm(kv_a, kv_a_norm) @ w_kv_b).reshape(bsz, s_len, MLA_HEADS, QK_NOPE + V_HEAD)
    k_nope, v = kv[..., :QK_NOPE], kv[..., QK_NOPE:]
    k_r = jnp.broadcast_to(k_rope[:, :, None, :], (bsz, s_len, MLA_HEADS, QK_ROPE))
    k = jnp.concatenate([k_nope, k_r], axis=-1)
    q = rms_norm(q, q_norm)
    k = rms_norm(k, k_norm)
    cos, sin = rope_tables(s_len, QK_ROPE)
    q = jnp.concatenate([q[..., :QK_NOPE], apply_rope(q[..., QK_NOPE:], cos, sin)], axis=-1)
    k = jnp.concatenate([k[..., :QK_NOPE], apply_rope(k[..., QK_NOPE:], cos, sin)], axis=-1)
    attn = dense_attention(q, k, v, QK_HEAD ** -0.5).reshape(bsz, s_len, MLA_WIDTH)
    cu = jnp.pad(gate_c * u, ((0, 0), (1, 1), (0, 0)))
    conv = cu[:, :-2] * conv_w[0] + cu[:, 1:-1] * conv_w[1] + cu[:, 2:] * conv_w[2]
    conv_out = gate_b * conv
    return jnp.concatenate([attn, conv_out], axis=-1) @ w_out


def window_gqa_mixer(h, w_in, q_norm, k_norm, sink, w_out):
    bsz, s_len, _ = h.shape
    nb = s_len // BLOCK
    z = h @ w_in
    q, k, v = jnp.split(z, [C_HEADS * C_HEAD_DIM, (C_HEADS + C_KV_HEADS) * C_HEAD_DIM], axis=-1)
    q = rms_norm(q.reshape(bsz, s_len, C_HEADS, C_HEAD_DIM), q_norm)
    k = rms_norm(k.reshape(bsz, s_len, C_KV_HEADS, C_HEAD_DIM), k_norm)
    v = v.reshape(bsz, s_len, C_KV_HEADS, C_HEAD_DIM)
    cos, sin = rope_tables(s_len, C_HEAD_DIM)
    q = apply_rope(q, cos, sin)
    k = apply_rope(k, cos, sin)
    qb = q.reshape(bsz, nb, BLOCK, C_KV_HEADS, C_GROUP, C_HEAD_DIM).transpose(1, 0, 2, 3, 4, 5)

    def band(t):
        tp = jnp.pad(t, ((0, 0), (BLOCK, BLOCK), (0, 0), (0, 0)))
        tp = tp.reshape(bsz, nb + 2, BLOCK, C_KV_HEADS, C_HEAD_DIM)
        tb = jnp.concatenate([tp[:, :-2], tp[:, 1:-1], tp[:, 2:]], axis=2)
        return tb.transpose(1, 0, 2, 3, 4)

    kb, vb = band(k), band(v)
    blk = jnp.arange(nb)[:, None, None] * BLOCK
    qpos = blk + jnp.arange(BLOCK)[None, :, None]
    kpos = blk - BLOCK + jnp.arange(3 * BLOCK)[None, None, :]
    valid = (jnp.abs(qpos - kpos) <= WINDOW) & (kpos >= 0) & (kpos < s_len)
    sink_f = sink.astype(jnp.float32).reshape(C_KV_HEADS, C_GROUP)

    def one_block(args):
        qblk, kblk, vblk, msk = args
        s = jnp.einsum('bqhgd,bkhd->bhgqk', qblk, kblk).astype(jnp.float32) * (C_HEAD_DIM ** -0.5)
        s = jnp.where(msk[None, None, None], s, NEG)
        sink_col = jnp.broadcast_to(sink_f[None, :, :, None, None], s.shape[:-1] + (1,))
        p = jax.nn.softmax(jnp.concatenate([s, sink_col], axis=-1), axis=-1)[..., :-1]
        return jnp.einsum('bhgqk,bkhd->bqhgd', p.astype(vblk.dtype), vblk)

    out = lax.map(one_block, (qb, kb, vb, valid))
    out = out.transpose(1, 0, 2, 3, 4, 5).reshape(bsz, s_len, C_HEADS * C_HEAD_DIM)
    return out @ w_out


def trunk(x, ffn_norm, ffn_w_gate, ffn_w_up, ffn_w_down, mix_norm,
          ab_w_in, ab_q_a_norm, ab_w_q_b, ab_kv_a_norm, ab_w_kv_b, ab_q_norm, ab_k_norm,
          ab_conv_w, ab_w_out, c_w_in, c_q_norm, c_k_norm, c_sink, c_w_out):
    for layer in range(DEPTH):
        x = x + 0.5 * swiglu(rms_norm(x, ffn_norm[layer, 0]), ffn_w_gate[layer, 0],
                             ffn_w_up[layer, 0], ffn_w_down[layer, 0])
        h = rms_norm(x, mix_norm[layer])
        i = layer // 2
        if layer % 2 == 0:
            x = x + mla_conv_mixer(h, ab_w_in[i], ab_q_a_norm[i], ab_w_q_b[i], ab_kv_a_norm[i],
                                   ab_w_kv_b[i], ab_q_norm[i], ab_k_norm[i], ab_conv_w[i], ab_w_out[i])
        else:
            x = x + window_gqa_mixer(h, c_w_in[i], c_q_norm[i], c_k_norm[i], c_sink[i], c_w_out[i])
        x = x + 0.5 * swiglu(rms_norm(x, ffn_norm[layer, 1]), ffn_w_gate[layer, 1],
                             ffn_w_up[layer, 1], ffn_w_down[layer, 1])
    return x


def setup_inputs(seed: int = 0) -> dict:
    key = jax.random.key(seed)
    ks = jax.random.split(key, 24)
    f32 = jnp.float32

    def w(k, shape, fan_in):
        return jax.random.normal(k, shape, f32) * (fan_in ** -0.5)

    def gain(k, shape):
        return 1.0 + 0.01 * jax.random.normal(k, shape, f32)

    return {
        "x_prompt": jax.random.normal(ks[0], (BATCH, SEQ, D_MODEL), f32),
        "x_sample": jax.random.normal(ks[1], (DEC_BATCH, DEC_SEQ, D_MODEL), f32),
        "ffn_norm": gain(ks[2], (DEPTH, 2, D_MODEL)),
        "ffn_w_gate": w(ks[3], (DEPTH, 2, D_MODEL, D_FF), D_MODEL),
        "ffn_w_up": w(ks[4], (DEPTH, 2, D_MODEL, D_FF), D_MODEL),
        "ffn_w_down": w(ks[5], (DEPTH, 2, D_FF, D_MODEL), D_FF),
        "mix_norm": gain(ks[6], (DEPTH, D_MODEL)),
        "ab_w_in": w(ks[7], (N_AB_LAYERS, D_MODEL, AB_IN), D_MODEL),
        "ab_q_a_norm": gain(ks[8], (N_AB_LAYERS, Q_LORA)),
        "ab_w_q_b": w(ks[9], (N_AB_LAYERS, Q_LORA, MLA_HEADS * QK_HEAD), Q_LORA),
        "ab_kv_a_norm": gain(ks[10], (N_AB_LAYERS, KV_LORA)),
        "ab_w_kv_b": w(ks[11], (N_AB_LAYERS, KV_LORA, MLA_HEADS * (QK_NOPE + V_HEAD)), KV_LORA),
        "ab_q_norm": gain(ks[12], (N_AB_LAYERS, QK_HEAD)),
        "ab_k_norm": gain(ks[13], (N_AB_LAYERS, QK_HEAD)),
        "ab_conv_w": w(ks[14], (N_AB_LAYERS, CONV_K, CONV_WIDTH), CONV_K),
        "ab_w_out": w(ks[15], (N_AB_LAYERS, D_MODEL, D_MODEL), D_MODEL),
        "c_w_in": w(ks[16], (N_C_LAYERS, D_MODEL, C_IN), D_MODEL),
        "c_q_norm": gain(ks[17], (N_C_LAYERS, C_HEAD_DIM)),
        "c_k_norm": gain(ks[18], (N_C_LAYERS, C_HEAD_DIM)),
        "c_sink": jax.random.normal(ks[19], (N_C_LAYERS, C_HEADS), f32),
        "c_w_out": w(ks[20], (N_C_LAYERS, C_HEADS * C_HEAD_DIM, D_MODEL), C_HEADS * C_HEAD_DIM),
    }


def reference(x_prompt, x_sample, ffn_norm, ffn_w_gate, ffn_w_up, ffn_w_down, mix_norm,
              ab_w_in, ab_q_a_norm, ab_w_q_b, ab_kv_a_norm, ab_w_kv_b, ab_q_norm, ab_k_norm,
              ab_conv_w, ab_w_out, c_w_in, c_q_norm, c_k_norm, c_sink, c_w_out):
    y_prompt = trunk(x_prompt, ffn_norm, ffn_w_gate, ffn_w_up, ffn_w_down, mix_norm,
                     ab_w_in, ab_q_a_norm, ab_w_q_b, ab_kv_a_norm, ab_w_kv_b, ab_q_norm, ab_k_norm,
                     ab_conv_w, ab_w_out, c_w_in, c_q_norm, c_k_norm, c_sink, c_w_out)
    y_sample = trunk(x_sample, ffn_norm, ffn_w_gate, ffn_w_up, ffn_w_down, mix_norm,
                     ab_w_in, ab_q_a_norm, ab_w_q_b, ab_kv_a_norm, ab_w_kv_b, ab_q_norm, ab_k_norm,
                     ab_conv_w, ab_w_out, c_w_in, c_q_norm, c_k_norm, c_sink, c_w_out)
    return (y_prompt, y_sample)
```

```cpp
#include <hip/hip_runtime.h>
#include <hip/hip_cooperative_groups.h>
#include <cstdio>
namespace cg = cooperative_groups;
#ifndef ONE_LAUNCH
#define ONE_LAUNCH 1
#endif
#ifndef PHM
#define PHM 63
#endif
namespace pg8 {
#define PG8_LAS __attribute__((address_space(3)))
typedef unsigned short bf16_t;
typedef short bf16x8 __attribute__((ext_vector_type(8)));
typedef float f32x4 __attribute__((ext_vector_type(4)));
typedef unsigned u32x4 __attribute__((ext_vector_type(4)));
constexpr int BM = 256, BK = 64, HALF = 128, HTB = HALF * BK * 2  , STAGE_BYTES = 8 * HTB, NXCD = 8, WGM = 8;

__host__ __device__ __forceinline__ int lds_byte(int r, int c) { const int st = (r >> 4) * 2 + (c >> 5), rr = r & 15, cc = c & 31, ob = rr * 64 + cc * 2; return st * 1024 + (ob ^ (((ob >> 9) & 1) << 5)); }
__host__ __device__ __forceinline__ void stage_rc(int b, int& R, int& C) { const int st = b / 1024, sb = b % 1024, swz = sb ^ (((sb >> 9) & 1) << 5); R = (st >> 1) * 16 + swz / 64; C = (st & 1) * 32 + (swz % 64) / 2; }
__host__ __device__ __forceinline__ int perm32(int rho) { const int n = rho >> 4, i = rho & 15; return 8 * (i >> 2) + 4 * n + (i & 3); }

struct Unit { int pm, pn; };
struct Gemm { const bf16_t* A; const bf16_t* Bt; int M, N, K; };

struct StaticOrder {
    int nM, nN, nwg, G, c;
    __host__ __device__ void init(int M, int N, int G_, int c_) { nM = M / BM; nN = N / BM; nwg = nM * nN; G = G_; c = c_; }
    __host__ __device__ bool next(int i, Unit& u) const {
        const long L = (long)i * G + c; if (L >= nwg) return false;
        int wgid = (int)L; { const int q = nwg / NXCD, r = nwg % NXCD, xcd = wgid % NXCD, off = wgid / NXCD; wgid = (xcd < r ? xcd * (q + 1) : r * (q + 1) + (xcd - r) * q) + off; }
        const int nig = WGM * nN, gid = wgid / nig, fm = gid * WGM, gsz = (nM - fm) < WGM ? (nM - fm) : WGM;
        u.pm = fm + ((wgid % nig) % gsz); u.pn = (wgid % nig) / gsz; return true;
    }
    __device__ __forceinline__ void a_ready(const Unit&) const {}
    __device__ __forceinline__ void done(const Unit&) const {}
};
__device__ __forceinline__ unsigned cvt_pk_bf16(float lo, float hi) { unsigned r; asm volatile("v_cvt_pk_bf16_f32 %0, %1, %2" : "=v"(r) : "v"(lo), "v"(hi)); return r; }
template <class Epi, class Sched, bool STAMP = false>
__device__ __forceinline__ void gemm_phase(PG8_LAS unsigned char* lds, const Gemm g, const Sched& S, const Epi& E, unsigned long long* stamps) {
    int tid_ = threadIdx.x; asm volatile("" : "+v"(tid_)); const int tid = tid_, wid = __builtin_amdgcn_readfirstlane(tid >> 6), lane = tid & 63, wr = wid >> 2, wc = wid & 3, fr = lane & 15, fq = lane >> 4;
    const int K = g.K, nt = K / BK;
    int ts_lo = 0, ts_hi = 0, nts = 0; const unsigned long long rt_entry = STAMP ? (unsigned long long)wall_clock64() : 0ull;
#define PG8_STAMP() do { if (STAMP && wid == 0 && nts < 64) { const unsigned long long _c = (unsigned long long)clock64(); \
        ts_lo = (lane == nts) ? (int)(unsigned)_c : ts_lo; ts_hi = (lane == nts) ? (int)(unsigned)(_c >> 32) : ts_hi; ++nts; } } while (0)
    PG8_STAMP();
    unsigned voffA[2], voffB[2];
#pragma unroll
    for (int i = 0; i < 2; ++i) { int R, C; stage_rc(tid * 16 + i * 8192, R, C); const int Rb = E.perm() ? ((R & ~31) + perm32(R & 31)) : R;
        voffA[i] = (unsigned)(R * K + C) * 2u; voffB[i] = (unsigned)(Rb * K + C) * 2u; }
    const size_t kstep = (size_t)(BK * 2);
    const size_t hstep = (size_t)HALF * K * 2;
    const size_t tstep = 2 * hstep;
    const unsigned ldsw = (unsigned)wid * 1024u;
    const int aoff = lds_byte(wr * 64 + fr, fq * 8), boff = lds_byte(wc * 32 + fr, fq * 8);
#define PG8_SA(b, h) (((b) * 2 + (h)) * HTB)
#define PG8_SB(b, h) ((4 + (b) * 2 + (h)) * HTB)
#define PG8_STAGE(bufoff, gbase, voff) do { _Pragma("unroll") for (int _i = 0; _i < 2; ++_i) \
        __builtin_amdgcn_global_load_lds((const unsigned*)((const char*)(gbase) + (voff)[_i]), (PG8_LAS unsigned*)(lds + (bufoff) + ldsw + _i * 8192), 16, 0, 0); } while (0)
#define PG8_LDA(dst, b, h) do { _Pragma("unroll") for (int m = 0; m < 4; ++m) _Pragma("unroll") for (int k = 0; k < 2; ++k) dst[m][k] = *(const PG8_LAS bf16x8*)(lds + PG8_SA(b, h) + aoff + m * 2048 + k * 1024); } while (0)
#define PG8_LDB(dst, b, h) do { _Pragma("unroll") for (int n = 0; n < 2; ++n) _Pragma("unroll") for (int k = 0; k < 2; ++k) dst[n][k] = *(const PG8_LAS bf16x8*)(lds + PG8_SB(b, h) + boff + n * 2048 + k * 1024); } while (0)
#define PG8_MMA(ai, bj, At, Bt) do { __builtin_amdgcn_s_setprio(1); _Pragma("unroll") for (int m = 0; m < 4; ++m) _Pragma("unroll") for (int n = 0; n < 2; ++n) _Pragma("unroll") for (int k = 0; k < 2; ++k) \
        acc[ai][bj][m][n] = __builtin_amdgcn_mfma_f32_16x16x32_bf16(Bt[n][k], At[m][k], acc[ai][bj][m][n], 0, 0, 0); __builtin_amdgcn_s_setprio(0); } while (0)
#define PG8_WAIT_V(n) asm volatile("s_waitcnt vmcnt(" #n ")" ::: "memory")
#define PG8_WAIT_L(n) asm volatile("s_waitcnt lgkmcnt(" #n ")" ::: "memory")
#define PG8_BAR __builtin_amdgcn_s_barrier()
#define PG8_SCHED __builtin_amdgcn_sched_barrier(0)
    Unit cur, nxt; int ui = 0;
    if (!S.next(0, cur)) return;
    f32x4 acc[2][2][4][2];
#pragma unroll
    for (int a = 0; a < 2; ++a)
#pragma unroll
        for (int b = 0; b < 2; ++b)
#pragma unroll
            for (int m = 0; m < 4; ++m)
#pragma unroll
                for (int n = 0; n < 2; ++n) acc[a][b][m][n] = (f32x4){0.f, 0.f, 0.f, 0.f};
    bf16x8 At[4][2], B0[2][2], B1[2][2];
    const char* cA = (const char*)g.A + (size_t)cur.pm * tstep; const char* cB = (const char*)g.Bt + (size_t)cur.pn * tstep;
    S.a_ready(cur);
    PG8_STAGE(PG8_SB(0, 0), cB, voffB); PG8_STAGE(PG8_SA(0, 0), cA, voffA); PG8_STAGE(PG8_SB(0, 1), cB + hstep, voffB); PG8_STAGE(PG8_SA(0, 1), cA + hstep, voffA);
    if (wr == 1) PG8_BAR;
    PG8_WAIT_V(4); PG8_BAR;
    PG8_STAGE(PG8_SB(1, 0), cB + kstep, voffB); PG8_STAGE(PG8_SA(1, 0), cA + kstep, voffA); PG8_STAGE(PG8_SB(1, 1), cB + hstep + kstep, voffB);
    PG8_WAIT_V(6); PG8_BAR;
    PG8_STAMP();
    for (;;) {
        const bool has_next = S.next(ui + 1, nxt);
        const char* nA = has_next ? (const char*)g.A + (size_t)nxt.pm * tstep : cA; const char* nB = has_next ? (const char*)g.Bt + (size_t)nxt.pn * tstep : cB;
        for (int t = 0; t < nt; t += 2) {
            const bool last = (t == nt - 2);
            const char* a1 = cA + (size_t)(t + 1) * kstep;
            const char* a2 = last ? nA : cA + (size_t)(t + 2) * kstep; const char* b2 = last ? nB : cB + (size_t)(t + 2) * kstep;
            const char* a3 = a2 + kstep; const char* b3 = b2 + kstep;
            if (last && has_next) S.a_ready(nxt);
            PG8_LDB(B0, 0, 0); PG8_SCHED; PG8_LDA(At, 0, 0); PG8_STAGE(PG8_SA(1, 1), a1 + hstep, voffA);
            PG8_WAIT_L(8); PG8_BAR; PG8_WAIT_L(0); PG8_MMA(0, 0, At, B0); PG8_BAR; PG8_SCHED;
            PG8_LDB(B1, 0, 1); PG8_STAGE(PG8_SB(0, 0), b2, voffB);
            PG8_BAR; PG8_WAIT_L(0); PG8_MMA(0, 1, At, B1); PG8_BAR;
            PG8_LDA(At, 0, 1); PG8_STAGE(PG8_SA(0, 0), a2, voffA);
            PG8_BAR; PG8_WAIT_L(0); PG8_MMA(1, 0, At, B0); PG8_BAR; PG8_SCHED;
            PG8_STAGE(PG8_SB(0, 1), b2 + hstep, voffB);
            PG8_WAIT_V(6); PG8_BAR; PG8_MMA(1, 1, At, B1); PG8_BAR;
            PG8_LDB(B0, 1, 0); PG8_SCHED; PG8_LDA(At, 1, 0); PG8_STAGE(PG8_SA(0, 1), a2 + hstep, voffA);
            PG8_WAIT_L(8); PG8_BAR; PG8_WAIT_L(0); PG8_MMA(0, 0, At, B0); PG8_BAR; PG8_SCHED;
            PG8_LDB(B1, 1, 1); PG8_STAGE(PG8_SB(1, 0), b3, voffB);
            PG8_BAR; PG8_WAIT_L(0); PG8_MMA(0, 1, At, B1); PG8_BAR;
            PG8_LDA(At, 1, 1); PG8_STAGE(PG8_SA(1, 0), a3, voffA);
            PG8_BAR; PG8_WAIT_L(0); PG8_MMA(1, 0, At, B0); PG8_BAR; PG8_SCHED;
            PG8_STAGE(PG8_SB(1, 1), b3 + hstep, voffB);
            PG8_WAIT_V(6); PG8_BAR; PG8_MMA(1, 1, At, B1); PG8_BAR;
        }
        PG8_STAMP();
        if constexpr (!Epi::AFTER_DRAIN) { E(acc, cur, wr, wc, fr, fq); S.done(cur); }
        PG8_STAMP();
        if (!has_next) break;
#pragma unroll
        for (int a = 0; a < 2; ++a)
#pragma unroll
            for (int b = 0; b < 2; ++b)
#pragma unroll
                for (int m = 0; m < 4; ++m)
#pragma unroll
                    for (int n = 0; n < 2; ++n) acc[a][b][m][n] = (f32x4){0.f, 0.f, 0.f, 0.f};
        cur = nxt; cA = nA; cB = nB; ++ui;
    }
    PG8_WAIT_V(0);
    if (wr == 0) PG8_BAR;
    PG8_BAR;
    if constexpr (Epi::AFTER_DRAIN) { E.fused(acc, cur, wr, wc, fr, fq, lds, wid, lane); S.done(cur); }
    PG8_STAMP();
    if (STAMP && wid == 0) { stamps[lane] = lane < nts ? (((unsigned long long)(unsigned)ts_hi << 32) | (unsigned)ts_lo) : 0ull;
        if (lane == 62) stamps[62] = rt_entry; if (lane == 63) stamps[63] = (unsigned long long)wall_clock64(); }
#undef PG8_STAMP
#undef PG8_SA
#undef PG8_SB
#undef PG8_STAGE
#undef PG8_LDA
#undef PG8_LDB
#undef PG8_MMA
#undef PG8_WAIT_V
#undef PG8_WAIT_L
#undef PG8_BAR
#undef PG8_SCHED
}
}

#define LAS __attribute__((address_space(3)))
typedef unsigned short bf16_t;
typedef short bf16x8 __attribute__((ext_vector_type(8)));
typedef float f32x4 __attribute__((ext_vector_type(4)));
typedef float f32x2 __attribute__((ext_vector_type(2)));
typedef float f32x16 __attribute__((ext_vector_type(16)));
typedef unsigned u32x4 __attribute__((ext_vector_type(4)));
typedef unsigned u32x2 __attribute__((ext_vector_type(2)));
typedef __bf16 bf16x2_t __attribute__((ext_vector_type(2)));

constexpr int DM = 2048, DFF = 5632, SEQ = 4096, NSEQ = 12, MTOT = NSEQ * SEQ, NPROMPT = 4 * SEQ;
constexpr int MC = 16384, NCH = MTOT / MC, SPC = MC / SEQ;
constexpr int ZW0 = 4352, ZW1 = 3072;
constexpr int NTHR = 512, LDS_BYTES = 131072;
constexpr float LOG2E = 1.4426950408889634f, EPSN = 1e-6f;

constexpr size_t SZ_WGU = (size_t)2 * DFF * DM * 2, SZ_WD = (size_t)DM * DFF * 2;
constexpr size_t OFF_WGU = 0;
constexpr size_t OFF_WD = OFF_WGU + 4 * SZ_WGU;
constexpr size_t OFF_WIN0 = OFF_WD + 4 * SZ_WD;
constexpr size_t OFF_WQB = OFF_WIN0 + (size_t)ZW0 * DM * 2;
constexpr size_t OFF_WKVB = OFF_WQB + (size_t)1536 * 512 * 2;
constexpr size_t OFF_WOUT0 = OFF_WKVB + (size_t)2048 * 512 * 2;
constexpr size_t OFF_WIN1 = OFF_WOUT0 + (size_t)DM * DM * 2;
constexpr size_t OFF_WOUT1 = OFF_WIN1 + (size_t)ZW1 * DM * 2;
constexpr size_t OFF_ROPE32 = OFF_WOUT1 + (size_t)DM * DM * 2;
constexpr size_t OFF_ROPE64 = OFF_ROPE32 + 2 * (size_t)SEQ * 32 * 4;
constexpr size_t OFF_HN = OFF_ROPE64 + 2 * (size_t)SEQ * 64 * 4;
constexpr size_t OFF_U = OFF_HN + (size_t)MC * DM * 2;
constexpr size_t OFF_H = OFF_U;
constexpr size_t OFF_Z = OFF_U;
constexpr size_t OFF_QA = OFF_Z + (size_t)MC * ZW0 * 2;
constexpr size_t OFF_KVA = OFF_QA + (size_t)MC * 512 * 2;
constexpr size_t OFF_QR = OFF_KVA + (size_t)MC * 512 * 2;
constexpr size_t OFF_KVR = OFF_QR + (size_t)MC * 1536 * 2;
constexpr size_t OFF_KF = OFF_KVR + (size_t)MC * 2048 * 2;
constexpr size_t OFF_VT = OFF_KF + (size_t)MC * 1536 * 2;
constexpr size_t OFF_ATT = OFF_VT + (size_t)MC * 1024 * 2;
constexpr size_t WS_END = OFF_ATT + (size_t)MC * 2048 * 2;

struct Params { const float* in[21]; float* out; unsigned char* ws; int ph_lo, ph_hi; };
enum { I_XP = 0, I_XS, I_FNORM, I_WG, I_WU, I_WDN, I_MNORM, I_ABIN, I_QANORM, I_WQB, I_KVANORM, I_WKVB, I_QNORM, I_KNORM, I_CONVW, I_ABOUT, I_CIN, I_CQN, I_CKN, I_CSINK, I_COUT };

__device__ __forceinline__ unsigned pk2(float a, float b) { f32x2 v = {a, b}; bf16x2_t r = __builtin_convertvector(v, bf16x2_t); return __builtin_bit_cast(unsigned, r); }
__device__ __forceinline__ float bflo(unsigned u) { return __uint_as_float(u << 16); }
__device__ __forceinline__ float bfhi(unsigned u) { return __uint_as_float(u & 0xffff0000u); }
__device__ __forceinline__ float bf1(bf16_t u) { return __uint_as_float(((unsigned)u) << 16); }
__device__ __forceinline__ bf16_t tobf(float a) { return (bf16_t)(pk2(a, 0.f) & 0xffffu); }
__device__ __forceinline__ int tid_opaque() { int t = threadIdx.x; asm volatile("" : "+v"(t)); return t; }
__device__ __forceinline__ float shflx(float v, int lane, int o) { return __int_as_float(__builtin_amdgcn_ds_bpermute((lane ^ o) << 2, __float_as_int(v))); }
__device__ __forceinline__ float wave_sum_l(float v, int lane) {
#pragma unroll
    for (int o = 32; o >= 1; o >>= 1) v += shflx(v, lane, o);
    return v;
}
#define OPAQUE(ptr) asm volatile("" : "+s"(ptr))

struct EpiStoreBf16 {
    static constexpr bool PERM = true, AFTER_DRAIN = false;
    bf16_t* O; int ldc;
    __device__ __forceinline__ void operator()(const f32x4 (&acc)[2][2][4][2], const pg8::Unit& u, int wr, int wc, int fr, int fq) const {
        const int row0 = u.pm * 256 + wr * 64 + fr, col0 = u.pn * 256 + wc * 32 + 8 * fq;
#pragma unroll
        for (int ai = 0; ai < 2; ++ai)
#pragma unroll
            for (int m = 0; m < 4; ++m) { bf16_t* rowp = O + (size_t)(row0 + ai * 128 + m * 16) * ldc + col0;
#pragma unroll
                for (int bj = 0; bj < 2; ++bj) { const f32x4 v0 = acc[ai][bj][m][0], v1 = acc[ai][bj][m][1];
                    u32x4 o = {pk2(v0[0], v0[1]), pk2(v0[2], v0[3]), pk2(v1[0], v1[1]), pk2(v1[2], v1[3])};
                    *(u32x4*)(rowp + bj * 128) = o; } }
    }
};
__device__ __forceinline__ float silu_mul(float g, float u) { return g * u * __builtin_amdgcn_rcpf(1.0f + __builtin_amdgcn_exp2f(-g * LOG2E)); }
struct EpiSwiglu {
    static constexpr bool PERM = true, AFTER_DRAIN = false;
    bf16_t* H; int ldc;
    __device__ __forceinline__ void operator()(const f32x4 (&acc)[2][2][4][2], const pg8::Unit& u, int wr, int wc, int fr, int fq) const {
        const int row0 = u.pm * 256 + wr * 64 + fr, col0 = u.pn * 128 + wc * 32 + 8 * fq;
#pragma unroll
        for (int ai = 0; ai < 2; ++ai)
#pragma unroll
            for (int m = 0; m < 4; ++m) { bf16_t* rowp = H + (size_t)(row0 + ai * 128 + m * 16) * ldc + col0;
                const f32x4 g0 = acc[ai][0][m][0], g1 = acc[ai][0][m][1], u0 = acc[ai][1][m][0], u1 = acc[ai][1][m][1];
                u32x4 o = {pk2(silu_mul(g0[0], u0[0]), silu_mul(g0[1], u0[1])), pk2(silu_mul(g0[2], u0[2]), silu_mul(g0[3], u0[3])),
                           pk2(silu_mul(g1[0], u1[0]), silu_mul(g1[1], u1[1])), pk2(silu_mul(g1[2], u1[2]), silu_mul(g1[3], u1[3]))};
                *(u32x4*)rowp = o; }
    }
};
struct EpiResid {
    static constexpr bool PERM = false, AFTER_DRAIN = false;
    float* dst; const float* src0; const float* src1; int split_row; int row_base; float scale;
    __device__ __forceinline__ void operator()(const f32x4 (&acc)[2][2][4][2], const pg8::Unit& u, int wr, int wc, int fr, int fq) const {
        const int grow0 = row_base + u.pm * 256 + wr * 64 + fr, col0 = u.pn * 256 + wc * 32 + 4 * fq;
#pragma unroll
        for (int ai = 0; ai < 2; ++ai)
#pragma unroll
            for (int m = 0; m < 4; ++m) { const int grow = grow0 + ai * 128 + m * 16;
                const float* sp = (grow < split_row ? src0 + (size_t)grow * DM : src1 + (size_t)(grow - split_row) * DM) + col0;
                float* dp = dst + (size_t)grow * DM + col0;
#pragma unroll
                for (int bj = 0; bj < 2; ++bj)
#pragma unroll
                    for (int n = 0; n < 2; ++n) { const f32x4 x = *(const f32x4*)(sp + bj * 128 + n * 16);
                        *(f32x4*)(dp + bj * 128 + n * 16) = x + scale * acc[ai][bj][m][n]; } }
    }
};

__device__ __forceinline__ int map_row(int mk, int n) {
    if (mk == 1) return (n >> 7) * 256 + (n & 127);
    if (mk == 2) return (n >> 7) * 256 + 128 + (n & 127);
    if (mk == 3) return n < 1024 ? n : (n < 1088 ? n + 3072 : n - 64);
    return n;
}
__device__ __forceinline__ void init_phase(const Params& p, LAS unsigned char* lds, unsigned char* ws) {
    const int tid = tid_opaque();
    LAS float* sm = (LAS float*)lds;
    for (int mi = 0; mi < 18; ++mi) {
        const float* src; int K, N, mk = 0; bf16_t* dst;
        if (mi < 12) { const int f = mi / 3, w = mi % 3;
            if (w == 0) { src = p.in[I_WG] + (size_t)f * DM * DFF; K = DM; N = DFF; dst = (bf16_t*)(ws + OFF_WGU + f * SZ_WGU); mk = 1; }
            else if (w == 1) { src = p.in[I_WU] + (size_t)f * DM * DFF; K = DM; N = DFF; dst = (bf16_t*)(ws + OFF_WGU + f * SZ_WGU); mk = 2; }
            else { src = p.in[I_WDN] + (size_t)f * DFF * DM; K = DFF; N = DM; dst = (bf16_t*)(ws + OFF_WD + f * SZ_WD); } }
        else if (mi == 12) { src = p.in[I_ABIN]; K = DM; N = 4160; dst = (bf16_t*)(ws + OFF_WIN0); mk = 3; }
        else if (mi == 13) { src = p.in[I_WQB]; K = 512; N = 1536; dst = (bf16_t*)(ws + OFF_WQB); }
        else if (mi == 14) { src = p.in[I_WKVB]; K = 512; N = 2048; dst = (bf16_t*)(ws + OFF_WKVB); }
        else if (mi == 15) { src = p.in[I_ABOUT]; K = DM; N = DM; dst = (bf16_t*)(ws + OFF_WOUT0); }
        else if (mi == 16) { src = p.in[I_CIN]; K = DM; N = 3072; dst = (bf16_t*)(ws + OFF_WIN1); }
        else { src = p.in[I_COUT]; K = DM; N = DM; dst = (bf16_t*)(ws + OFF_WOUT1); }
        const int tn = N >> 6, tk = K >> 8, nt = tn * tk;
        for (int t = blockIdx.x; t < nt; t += gridDim.x) {
            const int k0 = (t / tn) << 8, n0 = (t % tn) << 6;
            f32x4 v[8];
#pragma unroll
            for (int i = 0; i < 8; ++i) { const int r = (tid >> 4) + 32 * i, c4 = tid & 15; v[i] = *(const f32x4*)(src + (size_t)(k0 + r) * N + n0 + 4 * c4); }
#pragma unroll
            for (int i = 0; i < 8; ++i) { const int r = (tid >> 4) + 32 * i, c4 = tid & 15;
#pragma unroll
                for (int j = 0; j < 4; ++j) sm[r * 65 + 4 * c4 + j] = v[i][j]; }
            __syncthreads();
#pragma unroll
            for (int i = 0; i < 4; ++i) { const int q = tid + 512 * i, n = (q & 7) | (((q >> 6) & 7) << 3), kc = ((q >> 3) & 7) | ((q >> 9) << 3);
                float e[8];
#pragma unroll
                for (int j = 0; j < 8; ++j) e[j] = sm[(kc * 8 + j) * 65 + n];
                u32x4 o = {pk2(e[0], e[1]), pk2(e[2], e[3]), pk2(e[4], e[5]), pk2(e[6], e[7])};
                *(u32x4*)(dst + (size_t)map_row(mk, n0 + n) * K + k0 + kc * 8) = o; }
            __syncthreads();
        }
    }
    const int gt = blockIdx.x * NTHR + tid, gn = gridDim.x * NTHR;
    { u32x4* z = (u32x4*)(ws + OFF_WIN0 + (size_t)4160 * DM * 2); const int n16 = 192 * DM * 2 / 16; const u32x4 zero = {0u, 0u, 0u, 0u};
      for (int i = gt; i < n16; i += gn) z[i] = zero; }
    { float* c32 = (float*)(ws + OFF_ROPE32); float* s32 = c32 + SEQ * 32; float* c64 = (float*)(ws + OFF_ROPE64); float* s64 = c64 + SEQ * 64;
      for (int i = gt; i < SEQ * 32; i += gn) { const int pos = i >> 5, j = i & 31; const float inv = 1.0f / powf(10000.0f, (float)(2 * j) / 64.0f); const float ang = (float)pos * inv;
          const double a = (double)ang; const double kk = rint(a * 0.15915494309189535); const float rr = (float)(a - kk * 6.283185307179586);
          c32[i] = cosf(rr); s32[i] = sinf(rr); }
      for (int i = gt; i < SEQ * 64; i += gn) { const int pos = i >> 6, j = i & 63; const float inv = 1.0f / powf(10000.0f, (float)(2 * j) / 128.0f); const float ang = (float)pos * inv;
          const double a = (double)ang; const double kk = rint(a * 0.15915494309189535); const float rr = (float)(a - kk * 6.283185307179586);
          c64[i] = cosf(rr); s64[i] = sinf(rr); } }
}

__device__ __forceinline__ void norm_phase(const Params& p, unsigned char* ws, int chunk, bool from_input, const float* gain) {
    const int tid = tid_opaque(), lane = tid & 63, wave = tid >> 6;
    bf16_t* HN = (bf16_t*)(ws + OFF_HN);
    const float* xo = p.out; const float* xp = p.in[I_XP]; const float* xs = p.in[I_XS]; asm volatile("" : "+s"(xo)); asm volatile("" : "+s"(xp)); asm volatile("" : "+s"(xs));
    f32x4 g[8];
#pragma unroll
    for (int i = 0; i < 8; ++i) g[i] = *(const f32x4*)(gain + lane * 4 + 256 * i);
    for (int r = blockIdx.x * 8 + wave; r < MC; r += gridDim.x * 8) {
        const int grow = chunk * MC + r;
        const float* xr = from_input ? (grow < NPROMPT ? xp + (size_t)grow * DM : xs + (size_t)(grow - NPROMPT) * DM) : xo + (size_t)grow * DM;
        f32x4 v[8]; float ss = 0.f;
#pragma unroll
        for (int i = 0; i < 8; ++i) { v[i] = *(const f32x4*)(xr + lane * 4 + 256 * i); ss += v[i][0] * v[i][0] + v[i][1] * v[i][1] + v[i][2] * v[i][2] + v[i][3] * v[i][3]; }
        ss = wave_sum_l(ss, lane);
        const float rs = rsqrtf(ss * (1.0f / DM) + EPSN);
#pragma unroll
        for (int i = 0; i < 8; ++i) { u32x2 o = {pk2(v[i][0] * rs * g[i][0], v[i][1] * rs * g[i][1]), pk2(v[i][2] * rs * g[i][2], v[i][3] * rs * g[i][3])};
            *(u32x2*)(HN + (size_t)r * DM + lane * 4 + 256 * i) = o; }
    }
}
__device__ __forceinline__ void unpack8(const u32x4 u, float (&f)[8]) {
#pragma unroll
    for (int i = 0; i < 4; ++i) { f[2 * i] = bflo(u[i]); f[2 * i + 1] = bfhi(u[i]); }
}
__device__ __forceinline__ void mla_prep1(const Params& p, unsigned char* ws) {
    const int tid = tid_opaque(), lane = tid & 63, wave = tid >> 6;
    const bf16_t* Z = (const bf16_t*)(ws + OFF_Z); bf16_t* QA = (bf16_t*)(ws + OFF_QA); bf16_t* KVA = (bf16_t*)(ws + OFF_KVA); bf16_t* ATT = (bf16_t*)(ws + OFF_ATT);
    const float* gq = p.in[I_QANORM] + lane * 8; const float* gk = p.in[I_KVANORM] + lane * 8; const float* cw = p.in[I_CONVW] + lane * 16;
    for (int r = blockIdx.x * 8 + wave; r < MC; r += gridDim.x * 8) {
        const bf16_t* z = Z + (size_t)r * ZW0;
#pragma unroll
        for (int part = 0; part < 2; ++part) {
            float f[8]; unpack8(*(const u32x4*)(z + part * 512 + lane * 8), f);
            float ss = 0.f;
#pragma unroll
            for (int j = 0; j < 8; ++j) ss += f[j] * f[j];
            ss = wave_sum_l(ss, lane);
            const float rs = rsqrtf(ss * (1.0f / 512.0f) + EPSN);
            const float* g = part ? gk : gq;
            const f32x4 g0 = *(const f32x4*)g, g1 = *(const f32x4*)(g + 4);
            u32x4 o = {pk2(f[0] * rs * g0[0], f[1] * rs * g0[1]), pk2(f[2] * rs * g0[2], f[3] * rs * g0[3]), pk2(f[4] * rs * g1[0], f[5] * rs * g1[1]), pk2(f[6] * rs * g1[2], f[7] * rs * g1[3])};
            *(u32x4*)((part ? KVA : QA) + (size_t)r * 512 + lane * 8) = o;
        }
        const int t = r & (SEQ - 1);
#pragma unroll
        for (int hv = 0; hv < 2; ++hv) {
            const int c0 = lane * 16 + hv * 8;
            float gb[8], gc[8], uu[8], cu[8], acc[8];
            unpack8(*(const u32x4*)(z + 1024 + c0), gb);
            unpack8(*(const u32x4*)(z + 2048 + c0), gc); unpack8(*(const u32x4*)(z + 3072 + c0), uu);
            const f32x4 w1a = *(const f32x4*)(cw + 1024 + hv * 8), w1b = *(const f32x4*)(cw + 1024 + hv * 8 + 4);
#pragma unroll
            for (int j = 0; j < 8; ++j) { cu[j] = gc[j] * uu[j]; acc[j] = cu[j] * (j < 4 ? w1a[j] : w1b[j - 4]); }
            if (t > 0) { unpack8(*(const u32x4*)(z - ZW0 + 2048 + c0), gc); unpack8(*(const u32x4*)(z - ZW0 + 3072 + c0), uu);
                const f32x4 w0a = *(const f32x4*)(cw + hv * 8), w0b = *(const f32x4*)(cw + hv * 8 + 4);
#pragma unroll
                for (int j = 0; j < 8; ++j) acc[j] += gc[j] * uu[j] * (j < 4 ? w0a[j] : w0b[j - 4]); }
            if (t < SEQ - 1) { unpack8(*(const u32x4*)(z + ZW0 + 2048 + c0), gc); unpack8(*(const u32x4*)(z + ZW0 + 3072 + c0), uu);
                const f32x4 w2a = *(const f32x4*)(cw + 2048 + hv * 8), w2b = *(const f32x4*)(cw + 2048 + hv * 8 + 4);
#pragma unroll
                for (int j = 0; j < 8; ++j) acc[j] += gc[j] * uu[j] * (j < 4 ? w2a[j] : w2b[j - 4]); }
            u32x4 o = {pk2(gb[0] * acc[0], gb[1] * acc[1]), pk2(gb[2] * acc[2], gb[3] * acc[3]), pk2(gb[4] * acc[4], gb[5] * acc[5]), pk2(gb[6] * acc[6], gb[7] * acc[7])};
            *(u32x4*)(ATT + (size_t)r * DM + 1024 + c0) = o;
        }
    }
}
__device__ __forceinline__ void vt_transpose(LAS unsigned char* lds, const bf16_t* V, int ld, int coff, int hstride, int HK, bf16_t* VT) {
    const int tid = tid_opaque();
    LAS bf16_t* sm = (LAS bf16_t*)lds;
    const int ntile = (MC / 64) * HK;
    for (int tile = blockIdx.x; tile < ntile; tile += gridDim.x) {
        const int h = tile % HK, tb = tile / HK;
        const int row0 = tb * 64, seq = row0 / SEQ, t0 = row0 % SEQ;
#pragma unroll
        for (int i = 0; i < 2; ++i) { const int q = tid + 512 * i, t = q & 63, dc = q >> 6;
            const u32x4 v = *(const u32x4*)(V + (size_t)(row0 + t) * ld + coff + h * hstride + dc * 8);
#pragma unroll
            for (int j = 0; j < 4; ++j) { sm[(dc * 8 + 2 * j) * 72 + t] = (bf16_t)(v[j] & 0xffffu); sm[(dc * 8 + 2 * j + 1) * 72 + t] = (bf16_t)(v[j] >> 16); } }
        __syncthreads();
#pragma unroll
        for (int i = 0; i < 2; ++i) { const int q = tid + 512 * i, d = q >> 3, tc = q & 7;
            const u32x4 v = *(const LAS u32x4*)(sm + d * 72 + tc * 8);
            *(u32x4*)(VT + ((size_t)(seq * HK + h) * 128 + d) * SEQ + t0 + tc * 8) = v; }
        __syncthreads();
    }
}
__device__ __forceinline__ void mla_prep2(const Params& p, unsigned char* ws, LAS unsigned char* lds) {
    const int tid = tid_opaque(), lane = tid & 63, wave = tid >> 6;
    const bf16_t* Z = (const bf16_t*)(ws + OFF_Z); bf16_t* QR = (bf16_t*)(ws + OFF_QR); const bf16_t* KVR = (const bf16_t*)(ws + OFF_KVR); bf16_t* KF = (bf16_t*)(ws + OFF_KF);
    const float* c32 = (const float*)(ws + OFF_ROPE32); const float* s32 = c32 + SEQ * 32;
    const float* qn = p.in[I_QNORM]; const float* kn = p.in[I_KNORM];
    const float qn0 = qn[lane], qn1 = qn[64 + lane], qn2 = qn[128 + lane], kn0 = kn[lane], kn1 = kn[64 + lane], kn2 = kn[128 + lane];
    for (int r = blockIdx.x * 8 + wave; r < MC; r += gridDim.x * 8) {
        const int pos = r & (SEQ - 1);
        const float c = c32[pos * 32 + (lane & 31)], s = s32[pos * 32 + (lane & 31)];
        const float sgn = lane < 32 ? -s : s;
        bf16_t* q = QR + (size_t)r * 1536; const bf16_t* kv = KVR + (size_t)r * 2048; bf16_t* kf = KF + (size_t)r * 1536;
        const float kr = bf1(Z[(size_t)r * ZW0 + 4096 + lane]);
#pragma unroll 2
        for (int h = 0; h < 8; ++h) {
            { const float a0 = bf1(q[h * 192 + lane]), a1 = bf1(q[h * 192 + 64 + lane]), a2 = bf1(q[h * 192 + 128 + lane]);
              const float ss = wave_sum_l(a0 * a0 + a1 * a1 + a2 * a2, lane); const float rs = rsqrtf(ss * (1.0f / 192.0f) + EPSN);
              const float n2 = a2 * rs * qn2; const float pr = shflx(n2, lane, 32);
              q[h * 192 + lane] = tobf(a0 * rs * qn0); q[h * 192 + 64 + lane] = tobf(a1 * rs * qn1); q[h * 192 + 128 + lane] = tobf(n2 * c + pr * sgn); }
            { const float a0 = bf1(kv[h * 256 + lane]), a1 = bf1(kv[h * 256 + 64 + lane]);
              const float ss = wave_sum_l(a0 * a0 + a1 * a1 + kr * kr, lane); const float rs = rsqrtf(ss * (1.0f / 192.0f) + EPSN);
              const float n2 = kr * rs * kn2; const float pr = shflx(n2, lane, 32);
              kf[h * 192 + lane] = tobf(a0 * rs * kn0); kf[h * 192 + 64 + lane] = tobf(a1 * rs * kn1); kf[h * 192 + 128 + lane] = tobf(n2 * c + pr * sgn); }
        }
    }
    vt_transpose(lds, KVR, 2048, 128, 256, 8, (bf16_t*)(ws + OFF_VT));
}
__device__ __forceinline__ void gqa_prep(const Params& p, unsigned char* ws, LAS unsigned char* lds) {
    const int tid = tid_opaque(), lane = tid & 63, wave = tid >> 6;
    const bf16_t* Z = (const bf16_t*)(ws + OFF_Z); bf16_t* Q1 = (bf16_t*)(ws + OFF_KVR); bf16_t* K1 = (bf16_t*)(ws + OFF_QA);
    const float* c64 = (const float*)(ws + OFF_ROPE64); const float* s64 = c64 + SEQ * 64;
    const float qn0 = p.in[I_CQN][lane], qn1 = p.in[I_CQN][64 + lane], kn0 = p.in[I_CKN][lane], kn1 = p.in[I_CKN][64 + lane];
    for (int r = blockIdx.x * 8 + wave; r < MC; r += gridDim.x * 8) {
        const int pos = r & (SEQ - 1);
        const float c = c64[pos * 64 + lane], s = s64[pos * 64 + lane];
        const bf16_t* z = Z + (size_t)r * ZW1;
#pragma unroll 4
        for (int h = 0; h < 20; ++h) {
            const float a0 = bf1(z[h * 128 + lane]), a1 = bf1(z[h * 128 + 64 + lane]);
            const float ss = wave_sum_l(a0 * a0 + a1 * a1, lane); const float rs = rsqrtf(ss * (1.0f / 128.0f) + EPSN);
            const float n0 = a0 * rs * (h < 16 ? qn0 : kn0), n1 = a1 * rs * (h < 16 ? qn1 : kn1);
            bf16_t* o = h < 16 ? Q1 + (size_t)r * 2048 + h * 128 : K1 + (size_t)r * 512 + (h - 16) * 128;
            o[lane] = tobf(n0 * c - n1 * s); o[64 + lane] = tobf(n1 * c + n0 * s);
        }
    }
    vt_transpose(lds, Z, ZW1, 2560, 128, 4, (bf16_t*)(ws + OFF_VT));
}

template <int DQK, bool WIN>
__device__ __forceinline__ void attn_phase(LAS unsigned char* lds, const bf16_t* __restrict__ Q, int ldq, const bf16_t* __restrict__ K, int ldk,
                                           const bf16_t* __restrict__ VT, bf16_t* __restrict__ O, int HQ, int HK, const float* __restrict__ sink, float cscale) {
    constexpr int KS = DQK * 2 + 16, VS = 144, KB = 64 * KS, VB = 128 * VS, BUF = KB + VB, NKS = DQK / 16, KCH = DQK / 8, NKL = 64 * KCH / 512;
    static_assert(2 * BUF <= LDS_BYTES, "lds");
    const int tid = tid_opaque(), lane = tid & 63, wave = tid >> 6, l31 = lane & 31, hh = lane >> 5;
    const int pi = (l31 & 0x13) | ((l31 & 4) << 1) | ((l31 & 8) >> 1);
    const int G = HQ / HK, nitems = SPC * HQ * 16;
    for (int it = blockIdx.x; it < nitems; it += gridDim.x) {
        const int qb = it & 15, head = (it >> 4) % HQ, seq = it / (16 * HQ), hk = head / G;
        const int q0 = qb * 256, wq0 = q0 + wave * 32, qrow = wq0 + l31;
        bf16x8 qf[NKS];
        { const bf16_t* qp = Q + (size_t)(seq * SEQ + qrow) * ldq + head * DQK + hh * 8;
#pragma unroll
          for (int ks = 0; ks < NKS; ++ks) qf[ks] = *(const bf16x8*)(qp + ks * 16); }
        int kt_lo = 0, kt_hi = SEQ / 64;
        if (WIN) { kt_lo = (q0 - 128 > 0 ? q0 - 128 : 0) >> 6; kt_hi = (q0 + 384 < SEQ ? q0 + 384 : SEQ) >> 6; }
        const bf16_t* kbase = K + (size_t)(seq * SEQ) * ldk + hk * DQK;
        const bf16_t* vbase = VT + (size_t)((seq * HK + hk) * 128) * SEQ;
        f32x16 o[4];
#pragma unroll
        for (int db = 0; db < 4; ++db)
#pragma unroll
            for (int i = 0; i < 16; ++i) o[db][i] = 0.f;
        float m = WIN ? sink[head] * LOG2E : -1e30f;
        float lsum = (WIN && hh == 0) ? 1.f : 0.f;
        u32x4 kreg[NKL], vreg[2];
#define ATT_GLOAD(kt_) do { \
            _Pragma("unroll") for (int i_ = 0; i_ < NKL; ++i_) { const int ch_ = tid + 512 * i_, row_ = ch_ / KCH, cc_ = ch_ % KCH; kreg[i_] = *(const u32x4*)(kbase + (size_t)((kt_) * 64 + row_) * ldk + cc_ * 8); } \
            _Pragma("unroll") for (int i_ = 0; i_ < 2; ++i_) { const int ch_ = tid + 512 * i_, row_ = ch_ >> 3, cc_ = ch_ & 7; vreg[i_] = *(const u32x4*)(vbase + (size_t)row_ * SEQ + (kt_) * 64 + cc_ * 8); } } while (0)
#define ATT_LSTORE(b_) do { \
            _Pragma("unroll") for (int i_ = 0; i_ < NKL; ++i_) { const int ch_ = tid + 512 * i_, row_ = ch_ / KCH, cc_ = ch_ % KCH; *(LAS u32x4*)(lds + (b_) * BUF + row_ * KS + cc_ * 16) = kreg[i_]; } \
            _Pragma("unroll") for (int i_ = 0; i_ < 2; ++i_) { const int ch_ = tid + 512 * i_, row_ = ch_ >> 3, cc_ = ch_ & 7; *(LAS u32x4*)(lds + (b_) * BUF + KB + row_ * VS + cc_ * 16) = vreg[i_]; } } while (0)
        ATT_GLOAD(kt_lo); ATT_LSTORE(0); __syncthreads();
        for (int kt = kt_lo; kt < kt_hi; ++kt) {
            const int cur = (kt - kt_lo) & 1;
            const bool more = kt + 1 < kt_hi;
            if (more) ATT_GLOAD(kt + 1);
            bool need = true;
            if (WIN) need = (kt * 64 + 63 >= wq0 - 128) && (kt * 64 <= wq0 + 31 + 128);
            if (need) {
                LAS unsigned char* kb_ = lds + cur * BUF; LAS unsigned char* vb_ = kb_ + KB;
                f32x16 s[2];
#pragma unroll
                for (int kb2 = 0; kb2 < 2; ++kb2) {
#pragma unroll
                    for (int i = 0; i < 16; ++i) s[kb2][i] = 0.f;
#pragma unroll
                    for (int ks = 0; ks < NKS; ++ks) { const bf16x8 a = *(const LAS bf16x8*)(kb_ + (kb2 * 32 + pi) * KS + ks * 32 + hh * 16);
                        s[kb2] = __builtin_amdgcn_mfma_f32_32x32x16_bf16(a, qf[ks], s[kb2], 0, 0, 0); }
                }
                __builtin_amdgcn_sched_barrier(0);
                float mx = -1e30f;
#pragma unroll
                for (int kb2 = 0; kb2 < 2; ++kb2)
#pragma unroll
                    for (int ii = 0; ii < 16; ++ii) { float t = s[kb2][ii] * cscale;
                        if (WIN) { const int kp = kt * 64 + kb2 * 32 + 16 * (ii >> 3) + 8 * hh + (ii & 7); const int d = qrow - kp; t = (d <= 128 && d >= -128) ? t : -1e30f; }
                        s[kb2][ii] = t; mx = fmaxf(mx, t); }
                mx = fmaxf(mx, shflx(mx, lane, 32));
                const float mn = fmaxf(m, mx); const float alpha = __builtin_amdgcn_exp2f(m - mn); m = mn;
                float ps = 0.f;
#pragma unroll
                for (int kb2 = 0; kb2 < 2; ++kb2)
#pragma unroll
                    for (int ii = 0; ii < 16; ++ii) { const float pv = __builtin_amdgcn_exp2f(s[kb2][ii] - mn); s[kb2][ii] = pv; ps += pv; }
                lsum = lsum * alpha + ps;
#pragma unroll
                for (int db = 0; db < 4; ++db)
#pragma unroll
                    for (int i = 0; i < 16; ++i) o[db][i] *= alpha;
#pragma unroll
                for (int j = 0; j < 4; ++j) { const int kb2 = j >> 1, b8 = (j & 1) * 8; __builtin_amdgcn_sched_barrier(0);
                    u32x4 pb = {pk2(s[kb2][b8], s[kb2][b8 + 1]), pk2(s[kb2][b8 + 2], s[kb2][b8 + 3]), pk2(s[kb2][b8 + 4], s[kb2][b8 + 5]), pk2(s[kb2][b8 + 6], s[kb2][b8 + 7])};
                    const bf16x8 bfrag = __builtin_bit_cast(bf16x8, pb);
#pragma unroll
                    for (int db = 0; db < 4; ++db) { const bf16x8 a = *(const LAS bf16x8*)(vb_ + (db * 32 + l31) * VS + (16 * j + 8 * hh) * 2);
                        o[db] = __builtin_amdgcn_mfma_f32_32x32x16_bf16(a, bfrag, o[db], 0, 0, 0); } }
            }
            if (more) ATT_LSTORE(cur ^ 1);
            __syncthreads();
        }
#undef ATT_GLOAD
#undef ATT_LSTORE
        const float l = lsum + shflx(lsum, lane, 32); const float inv = 1.0f / l;
        bf16_t* op = O + (size_t)(seq * SEQ + qrow) * DM + head * 128 + 4 * hh;
#pragma unroll
        for (int db = 0; db < 4; ++db)
#pragma unroll
            for (int g = 0; g < 4; ++g) { u32x2 w = {pk2(o[db][4 * g] * inv, o[db][4 * g + 1] * inv), pk2(o[db][4 * g + 2] * inv, o[db][4 * g + 3] * inv)};
                *(u32x2*)(op + db * 32 + 8 * g) = w; }
    }
}

struct EpiAny {
    static constexpr bool AFTER_DRAIN = false;
    int mode; EpiStoreBf16 e0; EpiSwiglu e1; EpiResid e2;
    __device__ __forceinline__ bool perm() const { return mode != 2; }
    __device__ __forceinline__ void operator()(const f32x4 (&acc)[2][2][4][2], const pg8::Unit& u, int wr, int wc, int fr, int fq) const {
        if (mode == 0) e0(acc, u, wr, wc, fr, fq); else if (mode == 1) e1(acc, u, wr, wc, fr, fq); else e2(acc, u, wr, wc, fr, fq);
    }
};
constexpr int STEPS = 13, NPHASE = 1 + NCH * 2 * STEPS;
__device__ __forceinline__ bool run_phase(const Params& p, int ph, LAS unsigned char* lds) {
    unsigned char* ws = p.ws; OPAQUE(ws);
    const int q = ph - 1, step = q % STEPS, layer = (q / STEPS) & 1, chunk = q / (2 * STEPS);
    const bf16_t* HN = (const bf16_t*)(ws + OFF_HN);
    if (step == 0 || step == 3 || step == 10) {
        const float* g1 = p.in[I_MNORM]; const float* g2 = p.in[I_FNORM]; OPAQUE(g1); OPAQUE(g2);
        const float* gain = step == 3 ? g1 + layer * DM : g2 + (size_t)(layer * 2 + (step == 10)) * DM;
        if (PHM & 2) norm_phase(p, ws, chunk, layer == 0 && step == 0, gain);
        return true; }
    if (step == 5) { if (PHM & 8) { if (layer == 0) mla_prep1(p, ws); else gqa_prep(p, ws, lds); } return true; }
    if (step == 7) { if (layer) return false; if (PHM & 16) mla_prep2(p, ws, lds); return true; }
    if (step == 8) {
        if (!(PHM & 32)) return true;
        if (layer == 0) attn_phase<192, false>(lds, (const bf16_t*)(ws + OFF_QR), 1536, (const bf16_t*)(ws + OFF_KF), 1536, (const bf16_t*)(ws + OFF_VT), (bf16_t*)(ws + OFF_ATT), 8, 8, nullptr, 0.07216878364870322f * LOG2E);
        else attn_phase<128, true>(lds, (const bf16_t*)(ws + OFF_KVR), 2048, (const bf16_t*)(ws + OFF_QA), 512, (const bf16_t*)(ws + OFF_VT), (bf16_t*)(ws + OFF_ATT), 16, 4, p.in[I_CSINK], 0.08838834764831845f * LOG2E);
        return true; }
    if (step == 6 && layer) return false;
    const int njobs = step == 6 ? 2 : 1;
    for (int w = 0; w < njobs; ++w) {
        size_t offA, offB, offO = 0; int N, K, mode, ldc = 0; float scale = 1.0f; bool fi = false;
        if (step == 1 || step == 11) { const int f = layer * 2 + (step == 11); offA = OFF_HN; offB = OFF_WGU + f * SZ_WGU; N = 2 * DFF; K = DM; mode = 1; offO = OFF_H; ldc = DFF; }
        else if (step == 2 || step == 12) { const int f = layer * 2 + (step == 12); offA = OFF_H; offB = OFF_WD + f * SZ_WD; N = DM; K = DFF; mode = 2; scale = 0.5f; fi = (layer == 0 && step == 2); }
        else if (step == 4) { offA = OFF_HN; offB = layer ? OFF_WIN1 : OFF_WIN0; N = layer ? ZW1 : ZW0; K = DM; mode = 0; offO = OFF_Z; ldc = N; }
        else if (step == 6) { offA = w ? OFF_KVA : OFF_QA; offB = w ? OFF_WKVB : OFF_WQB; N = w ? 2048 : 1536; K = 512; mode = 0; offO = w ? OFF_KVR : OFF_QR; ldc = N; }
        else { offA = OFF_ATT; offB = layer ? OFF_WOUT1 : OFF_WOUT0; N = DM; K = DM; mode = 2; }
        EpiAny E; E.mode = mode;
        E.e0.O = (bf16_t*)(ws + offO); E.e0.ldc = ldc; E.e1.H = (bf16_t*)(ws + offO); E.e1.ldc = ldc;
        const float* xo = p.out; const float* xp = p.in[I_XP]; const float* xs = p.in[I_XS]; OPAQUE(xo); OPAQUE(xp); OPAQUE(xs);
        E.e2.dst = p.out; E.e2.src0 = fi ? xp : xo; E.e2.src1 = fi ? xs : xo; E.e2.split_row = fi ? NPROMPT : 0x7fffffff; E.e2.row_base = chunk * MC; E.e2.scale = scale;
        pg8::Gemm g; g.A = (const bf16_t*)(ws + offA); g.Bt = (const bf16_t*)(ws + offB); g.M = MC; g.N = N; g.K = K;
        pg8::StaticOrder S; S.init(MC, N, (int)gridDim.x, (int)blockIdx.x);
        if (PHM & 4) pg8::gemm_phase<EpiAny, pg8::StaticOrder, false>(lds, g, S, E, nullptr);
    }
    return true;
}
__global__ void __launch_bounds__(NTHR, 2) mega(Params p) {
    extern __shared__ __attribute__((aligned(16))) unsigned char smem[];
    LAS unsigned char* lds = (LAS unsigned char*)smem;
    cg::grid_group grid = cg::this_grid();
    int ph0 = p.ph_lo;
    if (ph0 == 0) {
        unsigned char* ws = p.ws; OPAQUE(ws);
        if (PHM & 1) init_phase(p, lds, ws);
        if (p.ph_hi > 1) grid.sync();
        ph0 = 1;
    }
    for (int ph = ph0; ph < p.ph_hi; ++ph) {
        const bool did = run_phase(p, ph, lds);
        if (did && ph + 1 < p.ph_hi) grid.sync();
    }
}

extern "C" void kernel_launch(void* const* d_in, const int* in_sizes, int n_in, void* d_out, int out_size, void* d_ws, size_t ws_size, hipStream_t stream) {
    static int grid = 0;
    if (grid == 0) {
        if (n_in != 21 || ws_size < WS_END || out_size != MTOT * DM) { fprintf(stderr, "kernel_launch: unexpected shapes (n_in %d, ws %zu need %zu, out %d)\n", n_in, ws_size, (size_t)WS_END, out_size); grid = -1; return; }
        int dev = 0, cus = 0, per_cu = 0;
        hipGetDevice(&dev);
        hipDeviceGetAttribute(&cus, hipDeviceAttributeMultiprocessorCount, dev);
        if (hipFuncSetAttribute((const void*)mega, hipFuncAttributeMaxDynamicSharedMemorySize, LDS_BYTES) != hipSuccess) { fprintf(stderr, "kernel_launch: hipFuncSetAttribute failed\n"); grid = -1; return; }
        if (hipOccupancyMaxActiveBlocksPerMultiprocessor(&per_cu, (const void*)mega, NTHR, LDS_BYTES) != hipSuccess || per_cu < 1) { fprintf(stderr, "kernel_launch: occupancy query says %d\n", per_cu); per_cu = 1; }
        (void)hipGetLastError();
        grid = cus * per_cu;
    }
    if (grid < 0) return;
    Params p{};
    for (int i = 0; i < 21; ++i) p.in[i] = (const float*)d_in[i];
    p.out = (float*)d_out; p.ws = (unsigned char*)d_ws;
#if ONE_LAUNCH
    p.ph_lo = 0; p.ph_hi = NPHASE;
    void* args[] = {&p};
    hipError_t e = hipLaunchCooperativeKernel((const void*)mega, dim3(grid), dim3(NTHR), args, LDS_BYTES, stream);
    if (e != hipSuccess) fprintf(stderr, "kernel_launch: cooperative launch failed: %s (grid %d)\n", hipGetErrorString(e), grid);
#else
    for (int ph = 0; ph < NPHASE; ++ph) {
        const int q = ph - 1, step = q % STEPS, layer = (q / STEPS) & 1;
        if (ph > 0 && layer == 1 && (step == 6 || step == 7)) continue;
        p.ph_lo = ph; p.ph_hi = ph + 1;
        hipLaunchKernelGGL(mega, dim3(grid), dim3(NTHR), LDS_BYTES, stream, p);
    }
#endif
}
```

```cpp
#include <hip/hip_runtime.h>
#include <hip/hip_cooperative_groups.h>
#include <cstdio>
namespace cg = cooperative_groups;
#ifndef ONE_LAUNCH
#define ONE_LAUNCH 1
#endif
#ifndef PHM
#define PHM 63
#endif
#ifndef REP_ATT
#define REP_ATT 1
#endif
#ifndef REP_GU
#define REP_GU 1
#endif
#ifndef REP_NORM
#define REP_NORM 1
#endif
#ifndef REP_SYNC
#define REP_SYNC 0
#endif
#ifndef REP_INIT
#define REP_INIT 1
#endif
#ifndef REP_PREP
#define REP_PREP 1
#endif
#ifndef REP_M0
#define REP_M0 1
#endif
#ifndef REP_RES
#define REP_RES 1
#endif
#ifndef WGM_RES
#define WGM_RES 4
#endif
#ifndef PREFETCH_B
#define PREFETCH_B 0
#endif
#ifndef WGM_GU
#define WGM_GU 8
#endif
#ifndef REV_GU
#define REV_GU 0
#endif
#ifndef WGM_M0
#define WGM_M0 4
#endif
namespace pg8 {
#define PG8_LAS __attribute__((address_space(3)))
typedef unsigned short bf16_t;
typedef short bf16x8 __attribute__((ext_vector_type(8)));
typedef float f32x4 __attribute__((ext_vector_type(4)));
typedef unsigned u32x4 __attribute__((ext_vector_type(4)));
constexpr int BM = 256, BK = 64, HALF = 128, HTB = HALF * BK * 2  , STAGE_BYTES = 8 * HTB, NXCD = 8, WGM = 8;

__host__ __device__ __forceinline__ int lds_byte(int r, int c) { const int st = (r >> 4) * 2 + (c >> 5), rr = r & 15, cc = c & 31, ob = rr * 64 + cc * 2; return st * 1024 + (ob ^ (((ob >> 9) & 1) << 5)); }
__host__ __device__ __forceinline__ void stage_rc(int b, int& R, int& C) { const int st = b / 1024, sb = b % 1024, swz = sb ^ (((sb >> 9) & 1) << 5); R = (st >> 1) * 16 + swz / 64; C = (st & 1) * 32 + (swz % 64) / 2; }
__host__ __device__ __forceinline__ int perm32(int rho) { const int n = rho >> 4, i = rho & 15; return 8 * (i >> 2) + 4 * n + (i & 3); }

struct Unit { int pm, pn; };
struct Gemm { const bf16_t* A; const bf16_t* Bt; int M, N, K, lda; };

struct StaticOrder {
    int nM, nN, nwg, G, c, wgm, rev;
    __host__ __device__ void init(int M, int N, int G_, int c_) { nM = M / BM; nN = N / BM; nwg = nM * nN; G = G_; c = c_; wgm = WGM; rev = 0; }
    __host__ __device__ bool next(int i, Unit& u) const {
        const long L = (long)i * G + c; if (L >= nwg) return false;
        int wgid = (int)L; { const int q = nwg / NXCD, r = nwg % NXCD, xcd = wgid % NXCD, off = wgid / NXCD; wgid = (xcd < r ? xcd * (q + 1) : r * (q + 1) + (xcd - r) * q) + off; }
        const int nig = wgm * nN, gid = wgid / nig, fm = gid * wgm, gsz = (nM - fm) < wgm ? (nM - fm) : wgm;
        u.pm = fm + ((wgid % nig) % gsz); u.pn = (wgid % nig) / gsz; if (rev) u.pn = nN - 1 - u.pn; return true;
    }
    __device__ __forceinline__ void a_ready(const Unit&) const {}
    __device__ __forceinline__ void done(const Unit&) const {}
};
__device__ __forceinline__ unsigned cvt_pk_bf16(float lo, float hi) { unsigned r; asm volatile("v_cvt_pk_bf16_f32 %0, %1, %2" : "=v"(r) : "v"(lo), "v"(hi)); return r; }
template <class Epi, class Sched, bool STAMP = false>
__device__ __forceinline__ void gemm_phase(PG8_LAS unsigned char* lds, const Gemm g, const Sched& S, const Epi& E, unsigned long long* stamps) {
    int tid_ = threadIdx.x; asm volatile("" : "+v"(tid_)); const int tid = tid_, wid = __builtin_amdgcn_readfirstlane(tid >> 6), lane = tid & 63, wr = wid >> 2, wc = wid & 3, fr = lane & 15, fq = lane >> 4;
    const int K = g.K, nt = K / BK;
    int ts_lo = 0, ts_hi = 0, nts = 0; const unsigned long long rt_entry = STAMP ? (unsigned long long)wall_clock64() : 0ull;
#define PG8_STAMP() do { if (STAMP && wid == 0 && nts < 64) { const unsigned long long _c = (unsigned long long)clock64(); \
        ts_lo = (lane == nts) ? (int)(unsigned)_c : ts_lo; ts_hi = (lane == nts) ? (int)(unsigned)(_c >> 32) : ts_hi; ++nts; } } while (0)
    PG8_STAMP();
    unsigned voffA[2], voffB[2];
#pragma unroll
    for (int i = 0; i < 2; ++i) { int R, C; stage_rc(tid * 16 + i * 8192, R, C); const int Rb = E.perm() ? ((R & ~31) + perm32(R & 31)) : R;
        voffA[i] = (unsigned)(R * g.lda + C) * 2u; voffB[i] = (unsigned)(Rb * K + C) * 2u; }
    const size_t kstep = (size_t)(BK * 2);
    const size_t hstep = (size_t)HALF * K * 2;
    const size_t tstep = 2 * hstep; const size_t hstepA = (size_t)HALF * g.lda * 2, tstepA = 2 * hstepA;
    const unsigned ldsw = (unsigned)wid * 1024u;
    const int aoff = lds_byte(wr * 64 + fr, fq * 8), boff = lds_byte(wc * 32 + fr, fq * 8);
#define PG8_SA(b, h) (((b) * 2 + (h)) * HTB)
#define PG8_SB(b, h) ((4 + (b) * 2 + (h)) * HTB)
#define PG8_STAGE(bufoff, gbase, voff) do { _Pragma("unroll") for (int _i = 0; _i < 2; ++_i) \
        __builtin_amdgcn_global_load_lds((const unsigned*)((const char*)(gbase) + (voff)[_i]), (PG8_LAS unsigned*)(lds + (bufoff) + ldsw + _i * 8192), 16, 0, 0); } while (0)
#define PG8_LDA(dst, b, h) do { _Pragma("unroll") for (int m = 0; m < 4; ++m) _Pragma("unroll") for (int k = 0; k < 2; ++k) dst[m][k] = *(const PG8_LAS bf16x8*)(lds + PG8_SA(b, h) + aoff + m * 2048 + k * 1024); } while (0)
#define PG8_LDB(dst, b, h) do { _Pragma("unroll") for (int n = 0; n < 2; ++n) _Pragma("unroll") for (int k = 0; k < 2; ++k) dst[n][k] = *(const PG8_LAS bf16x8*)(lds + PG8_SB(b, h) + boff + n * 2048 + k * 1024); } while (0)
#define PG8_MMA(ai, bj, At, Bt) do { __builtin_amdgcn_s_setprio(1); _Pragma("unroll") for (int m = 0; m < 4; ++m) _Pragma("unroll") for (int n = 0; n < 2; ++n) _Pragma("unroll") for (int k = 0; k < 2; ++k) \
        acc[ai][bj][m][n] = __builtin_amdgcn_mfma_f32_16x16x32_bf16(Bt[n][k], At[m][k], acc[ai][bj][m][n], 0, 0, 0); __builtin_amdgcn_s_setprio(0); } while (0)
#define PG8_WAIT_V(n) asm volatile("s_waitcnt vmcnt(" #n ")" ::: "memory")
#define PG8_WAIT_L(n) asm volatile("s_waitcnt lgkmcnt(" #n ")" ::: "memory")
#define PG8_BAR __builtin_amdgcn_s_barrier()
#define PG8_SCHED __builtin_amdgcn_sched_barrier(0)
    Unit cur, nxt; int ui = 0;
    if (!S.next(0, cur)) return;
    f32x4 acc[2][2][4][2];
#pragma unroll
    for (int a = 0; a < 2; ++a)
#pragma unroll
        for (int b = 0; b < 2; ++b)
#pragma unroll
            for (int m = 0; m < 4; ++m)
#pragma unroll
                for (int n = 0; n < 2; ++n) acc[a][b][m][n] = (f32x4){0.f, 0.f, 0.f, 0.f};
    bf16x8 At[4][2], B0[2][2], B1[2][2];
    const char* cA = (const char*)g.A + (size_t)cur.pm * tstepA; const char* cB = (const char*)g.Bt + (size_t)cur.pn * tstep;
    S.a_ready(cur);
    PG8_STAGE(PG8_SB(0, 0), cB, voffB); PG8_STAGE(PG8_SA(0, 0), cA, voffA); PG8_STAGE(PG8_SB(0, 1), cB + hstep, voffB); PG8_STAGE(PG8_SA(0, 1), cA + hstepA, voffA);
    if (wr == 1) PG8_BAR;
    PG8_WAIT_V(4); PG8_BAR;
    PG8_STAGE(PG8_SB(1, 0), cB + kstep, voffB); PG8_STAGE(PG8_SA(1, 0), cA + kstep, voffA); PG8_STAGE(PG8_SB(1, 1), cB + hstep + kstep, voffB);
    PG8_WAIT_V(6); PG8_BAR;
    PG8_STAMP();
    for (;;) {
        const bool has_next = S.next(ui + 1, nxt);
        const char* nA = has_next ? (const char*)g.A + (size_t)nxt.pm * tstepA : cA; const char* nB = has_next ? (const char*)g.Bt + (size_t)nxt.pn * tstep : cB;
        for (int t = 0; t < nt; t += 2) {
            const bool last = (t == nt - 2);
            const char* a1 = cA + (size_t)(t + 1) * kstep;
            const char* a2 = last ? nA : cA + (size_t)(t + 2) * kstep; const char* b2 = last ? nB : cB + (size_t)(t + 2) * kstep;
            const char* a3 = a2 + kstep; const char* b3 = b2 + kstep;
            if (last && has_next) S.a_ready(nxt);
            if (last) E.pre(cur, wr, fr, tid);
            PG8_LDB(B0, 0, 0); PG8_SCHED; PG8_LDA(At, 0, 0); PG8_STAGE(PG8_SA(1, 1), a1 + hstepA, voffA);
            PG8_WAIT_L(8); PG8_BAR; PG8_WAIT_L(0); PG8_MMA(0, 0, At, B0); PG8_BAR; PG8_SCHED;
            PG8_LDB(B1, 0, 1); PG8_STAGE(PG8_SB(0, 0), b2, voffB);
            PG8_BAR; PG8_WAIT_L(0); PG8_MMA(0, 1, At, B1); PG8_BAR;
            PG8_LDA(At, 0, 1); PG8_STAGE(PG8_SA(0, 0), a2, voffA);
            PG8_BAR; PG8_WAIT_L(0); PG8_MMA(1, 0, At, B0); PG8_BAR; PG8_SCHED;
            PG8_STAGE(PG8_SB(0, 1), b2 + hstep, voffB);
            PG8_WAIT_V(6); PG8_BAR; PG8_MMA(1, 1, At, B1); PG8_BAR;
            PG8_LDB(B0, 1, 0); PG8_SCHED; PG8_LDA(At, 1, 0); PG8_STAGE(PG8_SA(0, 1), a2 + hstepA, voffA);
            PG8_WAIT_L(8); PG8_BAR; PG8_WAIT_L(0); PG8_MMA(0, 0, At, B0); PG8_BAR; PG8_SCHED;
            PG8_LDB(B1, 1, 1); PG8_STAGE(PG8_SB(1, 0), b3, voffB);
            PG8_BAR; PG8_WAIT_L(0); PG8_MMA(0, 1, At, B1); PG8_BAR;
            PG8_LDA(At, 1, 1); PG8_STAGE(PG8_SA(1, 0), a3, voffA);
            PG8_BAR; PG8_WAIT_L(0); PG8_MMA(1, 0, At, B0); PG8_BAR; PG8_SCHED;
            PG8_STAGE(PG8_SB(1, 1), b3 + hstep, voffB);
            PG8_WAIT_V(6); PG8_BAR; PG8_MMA(1, 1, At, B1); PG8_BAR;
        }
        PG8_STAMP();
        if constexpr (!Epi::AFTER_DRAIN) { E(acc, cur, wr, wc, fr, fq); S.done(cur); }
        PG8_STAMP();
        if (!has_next) break;
#pragma unroll
        for (int a = 0; a < 2; ++a)
#pragma unroll
            for (int b = 0; b < 2; ++b)
#pragma unroll
                for (int m = 0; m < 4; ++m)
#pragma unroll
                    for (int n = 0; n < 2; ++n) acc[a][b][m][n] = (f32x4){0.f, 0.f, 0.f, 0.f};
        cur = nxt; cA = nA; cB = nB; ++ui;
    }
    PG8_WAIT_V(0);
    if (wr == 0) PG8_BAR;
    PG8_BAR;
    if constexpr (Epi::AFTER_DRAIN) { E.fused(acc, cur, wr, wc, fr, fq, lds, wid, lane); S.done(cur); }
    PG8_STAMP();
    if (STAMP && wid == 0) { stamps[lane] = lane < nts ? (((unsigned long long)(unsigned)ts_hi << 32) | (unsigned)ts_lo) : 0ull;
        if (lane == 62) stamps[62] = rt_entry; if (lane == 63) stamps[63] = (unsigned long long)wall_clock64(); }
#undef PG8_STAMP
#undef PG8_SA
#undef PG8_SB
#undef PG8_STAGE
#undef PG8_LDA
#undef PG8_LDB
#undef PG8_MMA
#undef PG8_WAIT_V
#undef PG8_WAIT_L
#undef PG8_BAR
#undef PG8_SCHED
}
}

#define LAS __attribute__((address_space(3)))
typedef unsigned short bf16_t;
typedef short bf16x8 __attribute__((ext_vector_type(8)));
typedef float f32x4 __attribute__((ext_vector_type(4)));
typedef float f32x2 __attribute__((ext_vector_type(2)));
typedef float f32x16 __attribute__((ext_vector_type(16)));
typedef unsigned u32x4 __attribute__((ext_vector_type(4)));
typedef unsigned u32x2 __attribute__((ext_vector_type(2)));
typedef __bf16 bf16x2_t __attribute__((ext_vector_type(2)));

constexpr int DM = 2048, DFF = 5632, SEQ = 4096, NSEQ = 12, MTOT = NSEQ * SEQ, NPROMPT = 4 * SEQ;
constexpr int MC = 16384, NCH = MTOT / MC, SPC = MC / SEQ;
constexpr int ZW0 = 4352, ZW1 = 3072;
constexpr int NTHR = 512, LDS_STAGE = 132096, LDS_BYTES = LDS_STAGE + 256;
constexpr float LOG2E = 1.4426950408889634f, EPSN = 1e-6f;

constexpr size_t SZ_WGU = (size_t)2 * DFF * DM * 2, SZ_WD = (size_t)DM * DFF * 2;
constexpr size_t OFF_WGU = 0;
constexpr size_t OFF_WD = OFF_WGU + 4 * SZ_WGU;
constexpr size_t OFF_WIN0 = OFF_WD + 4 * SZ_WD;
constexpr size_t OFF_WQB = OFF_WIN0 + (size_t)ZW0 * DM * 2;
constexpr size_t OFF_WKVB = OFF_WQB + (size_t)1536 * 512 * 2;
constexpr size_t OFF_WOUT0 = OFF_WKVB + (size_t)2048 * 512 * 2;
constexpr size_t OFF_WIN1 = OFF_WOUT0 + (size_t)DM * DM * 2;
constexpr size_t OFF_WOUT1 = OFF_WIN1 + (size_t)ZW1 * DM * 2;
constexpr size_t OFF_ROPE32 = OFF_WOUT1 + (size_t)DM * DM * 2;
constexpr size_t OFF_ROPE64 = OFF_ROPE32 + 2 * (size_t)SEQ * 32 * 4;
constexpr size_t OFF_SSQ = OFF_ROPE64 + 2 * (size_t)SEQ * 64 * 4;
constexpr size_t OFF_SSQ2 = OFF_SSQ + 6 * (size_t)MTOT * 4;
constexpr size_t OFF_XB = OFF_SSQ2 + 2 * (size_t)MTOT * 4;
constexpr size_t OFF_U = OFF_XB + (size_t)MTOT * DM * 2;
constexpr size_t OFF_H = OFF_U;
constexpr size_t OFF_Z = OFF_U;
constexpr size_t OFF_QA = OFF_Z + (size_t)MC * ZW0 * 2;
constexpr size_t OFF_KVA = OFF_QA + (size_t)MC * 512 * 2;
constexpr size_t OFF_QR = OFF_KVA + (size_t)MC * 512 * 2;
constexpr size_t OFF_KVR = OFF_QR + (size_t)MC * 1536 * 2;
constexpr size_t OFF_KF = OFF_KVR + (size_t)MC * 2048 * 2;
constexpr size_t OFF_VT = OFF_KF + (size_t)MC * 1536 * 2;
constexpr size_t OFF_ATT = OFF_VT + (size_t)MC * 1024 * 2;
constexpr size_t OFF_UEND = OFF_ATT + (size_t)MC * 2048 * 2;
constexpr size_t OFF_BAR = OFF_UEND;
static_assert((size_t)MC * DFF * 2 <= OFF_UEND - OFF_U, "H must fit in the union");
constexpr size_t BAR_BYTES = 16384;
constexpr size_t WS_END = OFF_BAR + BAR_BYTES;

struct Params { const float* in[21]; float* out; unsigned char* ws; int ph_lo, ph_hi; };
enum { I_XP = 0, I_XS, I_FNORM, I_WG, I_WU, I_WDN, I_MNORM, I_ABIN, I_QANORM, I_WQB, I_KVANORM, I_WKVB, I_QNORM, I_KNORM, I_CONVW, I_ABOUT, I_CIN, I_CQN, I_CKN, I_CSINK, I_COUT };

__device__ __forceinline__ unsigned pk2(float a, float b) { f32x2 v = {a, b}; bf16x2_t r = __builtin_convertvector(v, bf16x2_t); return __builtin_bit_cast(unsigned, r); }
__device__ __forceinline__ float bflo(unsigned u) { return __uint_as_float(u << 16); }
__device__ __forceinline__ float bfhi(unsigned u) { return __uint_as_float(u & 0xffff0000u); }
__device__ __forceinline__ float bf1(bf16_t u) { return __uint_as_float(((unsigned)u) << 16); }
__device__ __forceinline__ bf16_t tobf(float a) { return (bf16_t)(pk2(a, 0.f) & 0xffffu); }
__device__ __forceinline__ int tid_opaque() { int t = threadIdx.x; asm volatile("" : "+v"(t)); return t; }
__device__ __forceinline__ float shflx(float v, int lane, int o) { return __int_as_float(__builtin_amdgcn_ds_bpermute((lane ^ o) << 2, __float_as_int(v))); }
__device__ __forceinline__ float wave_sum_l(float v, int lane) {
#pragma unroll
    for (int o = 32; o >= 1; o >>= 1) v += shflx(v, lane, o);
    return v;
}
#define OPAQUE(ptr) asm volatile("" : "+s"(ptr))

constexpr float FXS = 4096.0f;
__device__ __forceinline__ void fx_add(float* slot, float part) { (void)__hip_atomic_fetch_add((unsigned*)slot, (unsigned)(part * FXS + 0.5f), __ATOMIC_RELAXED, __HIP_MEMORY_SCOPE_AGENT); }
__device__ __forceinline__ float row_rs(const float* ssq, int grow) { return ssq ? rsqrtf(ssq[grow] * (1.0f / DM) + EPSN) : 1.0f; }
struct EpiStoreBf16 {
    static constexpr bool AFTER_DRAIN = false;
    bf16_t* O; const float* ssq; float* sq2; int ldc; float inv_n;
    __device__ __forceinline__ void operator()(const f32x4 (&acc)[2][2][4][2], const pg8::Unit& u, int wr, int wc, int fr, int fq, const float (&pre)[8]) const {
        const int row0 = u.pm * 256 + wr * 64 + fr, col0 = u.pn * 256 + wc * 32 + 8 * fq, lane = fq * 16 + fr;
        const bool acc2 = sq2 != nullptr && u.pn < 4;
#pragma unroll
        for (int ai = 0; ai < 2; ++ai)
#pragma unroll
            for (int m = 0; m < 4; ++m) { const int row = row0 + ai * 128 + m * 16; bf16_t* rowp = O + (size_t)row * ldc + col0;
                const float rs = ssq ? rsqrtf((float)__float_as_uint(pre[ai * 4 + m]) * (inv_n * (1.0f / FXS)) + EPSN) : 1.0f;
                float part = 0.f;
#pragma unroll
                for (int bj = 0; bj < 2; ++bj) { const f32x4 v0 = acc[ai][bj][m][0] * rs, v1 = acc[ai][bj][m][1] * rs;
                    u32x4 o = {pk2(v0[0], v0[1]), pk2(v0[2], v0[3]), pk2(v1[0], v1[1]), pk2(v1[2], v1[3])};
                    *(u32x4*)(rowp + bj * 128) = o;
                    if (acc2) part += v0[0] * v0[0] + v0[1] * v0[1] + v0[2] * v0[2] + v0[3] * v0[3] + v1[0] * v1[0] + v1[1] * v1[1] + v1[2] * v1[2] + v1[3] * v1[3]; }
                if (acc2) { part += shflx(part, lane, 16); part += shflx(part, lane, 32);
                    if (fq == 0) fx_add(sq2 + (size_t)(u.pn >> 1) * MTOT + row, part); } }
    }
};
__device__ __forceinline__ unsigned silu_mul_pk(f32x2 g, f32x2 u, f32x2 c1  , f32x2 c2  ) {
    const f32x2 a = g * c1;
    f32x2 e; e[0] = __builtin_amdgcn_exp2f(a[0]); e[1] = __builtin_amdgcn_exp2f(a[1]);
    const f32x2 d = e + 1.0f;
    f32x2 r; r[0] = __builtin_amdgcn_rcpf(d[0]); r[1] = __builtin_amdgcn_rcpf(d[1]);
    const f32x2 o = ((g * u) * c2) * r;
    return pk2(o[0], o[1]);
}
struct EpiSwiglu {
    static constexpr bool AFTER_DRAIN = false;
    bf16_t* H; const float* ssq; int ldc; int pad_;
    __device__ __forceinline__ void operator()(const f32x4 (&acc)[2][2][4][2], const pg8::Unit& u, int wr, int wc, int fr, int fq, const float (&pre)[8]) const {
        const int row0 = u.pm * 256 + wr * 64 + fr, col0 = u.pn * 128 + wc * 32 + 8 * fq;
#pragma unroll
        for (int ai = 0; ai < 2; ++ai)
#pragma unroll
            for (int m = 0; m < 4; ++m) { const int row = row0 + ai * 128 + m * 16; bf16_t* rowp = H + (size_t)row * ldc + col0;
                const float rs = rsqrtf((float)__float_as_uint(pre[ai * 4 + m]) * (1.0f / (DM * FXS)) + EPSN);
                const float k1 = -rs * LOG2E, k2 = rs * rs; const f32x2 c1 = {k1, k1}, c2 = {k2, k2};
                const f32x4 g0 = acc[ai][0][m][0], g1 = acc[ai][0][m][1], u0 = acc[ai][1][m][0], u1 = acc[ai][1][m][1];
                u32x4 o = {silu_mul_pk((f32x2){g0[0], g0[1]}, (f32x2){u0[0], u0[1]}, c1, c2), silu_mul_pk((f32x2){g0[2], g0[3]}, (f32x2){u0[2], u0[3]}, c1, c2),
                           silu_mul_pk((f32x2){g1[0], g1[1]}, (f32x2){u1[0], u1[1]}, c1, c2), silu_mul_pk((f32x2){g1[2], g1[3]}, (f32x2){u1[2], u1[3]}, c1, c2)};
                *(u32x4*)rowp = o; }
    }
};
typedef const float __attribute__((address_space(1)))* gcf_t;
typedef float __attribute__((address_space(1)))* gf_t;
typedef bf16_t __attribute__((address_space(1)))* gb_t;
struct EpiResid {
    static constexpr bool AFTER_DRAIN = false;
    float* dst; const float* src0; const float* src1; bf16_t* xb; float* ssq_out; int split_row; int row_base; float scale; int fi;
    __device__ __forceinline__ void operator()(const f32x4 (&acc)[2][2][4][2], const pg8::Unit& u, int wr, int wc, int fr, int fq) const {
        const int grow0 = row_base + u.pm * 256 + wr * 64 + fr, col0 = u.pn * 256 + wc * 32 + 8 * fq, lane = fq * 16 + fr;
        const gf_t dbase = (gf_t)dst + (size_t)grow0 * DM + col0;
        const gb_t xbase = (gb_t)xb + (size_t)grow0 * DM + col0;
        const bool wx = ssq_out != nullptr, wf = dst != nullptr;
        if (fi) {
            const bool lo = (row_base + u.pm * 256) < split_row;
            const gcf_t sbase = (gcf_t)(lo ? src0 : src1 - (size_t)split_row * DM) + (size_t)grow0 * DM + col0;
            f32x4 xv[2][8];
#define RESID_LOAD(buf, jp) do { _Pragma("unroll") for (int jj = 0; jj < 2; ++jj) { const int j_ = (jp) * 2 + jj, ai_ = j_ >> 2, m_ = j_ & 3; \
            _Pragma("unroll") for (int c_ = 0; c_ < 4; ++c_) xv[buf][jj * 4 + c_] = *(const f32x4 __attribute__((address_space(1)))*)(sbase + (size_t)(ai_ * 128 + m_ * 16) * DM + (c_ >> 1) * 128 + (c_ & 1) * 4); } } while (0)
            RESID_LOAD(0, 0);
#pragma unroll
            for (int jp = 0; jp < 4; ++jp) {
                if (jp + 1 < 4) { if ((jp & 1) == 0) RESID_LOAD(1, jp + 1); else RESID_LOAD(0, jp + 1); }
#pragma unroll
                for (int jj = 0; jj < 2; ++jj) { const int j = jp * 2 + jj, ai = j >> 2, m = j & 3; const size_t ro = (size_t)(ai * 128 + m * 16) * DM;
                    float part = 0.f;
#pragma unroll
                    for (int bj = 0; bj < 2; ++bj) {
                        const f32x4 v0 = xv[jp & 1][jj * 4 + bj * 2] + scale * acc[ai][bj][m][0], v1 = xv[jp & 1][jj * 4 + bj * 2 + 1] + scale * acc[ai][bj][m][1];
                        u32x4 o = {pk2(v0[0], v0[1]), pk2(v0[2], v0[3]), pk2(v1[0], v1[1]), pk2(v1[2], v1[3])};
                        *(u32x4 __attribute__((address_space(1)))*)(xbase + ro + bj * 128) = o;
                        part += v0[0] * v0[0] + v0[1] * v0[1] + v0[2] * v0[2] + v0[3] * v0[3] + v1[0] * v1[0] + v1[1] * v1[1] + v1[2] * v1[2] + v1[3] * v1[3]; }
                    part += shflx(part, lane, 16); part += shflx(part, lane, 32);
                    if (fq == 0) fx_add(ssq_out + grow0 + ai * 128 + m * 16, part); }
            }
#undef RESID_LOAD
        } else {
            u32x4 raw[16];
#pragma unroll
            for (int j = 0; j < 8; ++j)
#pragma unroll
                for (int bj = 0; bj < 2; ++bj) raw[j * 2 + bj] = *(const u32x4 __attribute__((address_space(1)))*)(xbase + (size_t)((j >> 2) * 128 + (j & 3) * 16) * DM + bj * 128);
#pragma unroll
            for (int j = 0; j < 8; ++j) { const int ai = j >> 2, m = j & 3; const size_t ro = (size_t)(ai * 128 + m * 16) * DM;
                float part = 0.f;
#pragma unroll
                for (int bj = 0; bj < 2; ++bj) { const u32x4 rw = raw[j * 2 + bj];
                    const f32x4 x0 = {bflo(rw[0]), bfhi(rw[0]), bflo(rw[1]), bfhi(rw[1])}, x1 = {bflo(rw[2]), bfhi(rw[2]), bflo(rw[3]), bfhi(rw[3])};
                    const f32x4 v0 = x0 + scale * acc[ai][bj][m][0], v1 = x1 + scale * acc[ai][bj][m][1];
                    if (wf) { *(f32x4 __attribute__((address_space(1)))*)(dbase + ro + bj * 128) = v0; *(f32x4 __attribute__((address_space(1)))*)(dbase + ro + bj * 128 + 4) = v1; }
                    if (wx) { u32x4 o = {pk2(v0[0], v0[1]), pk2(v0[2], v0[3]), pk2(v1[0], v1[1]), pk2(v1[2], v1[3])};
                        *(u32x4 __attribute__((address_space(1)))*)(xbase + ro + bj * 128) = o;
                        part += v0[0] * v0[0] + v0[1] * v0[1] + v0[2] * v0[2] + v0[3] * v0[3] + v1[0] * v1[0] + v1[1] * v1[1] + v1[2] * v1[2] + v1[3] * v1[3]; } }
                if (wx) { part += shflx(part, lane, 16); part += shflx(part, lane, 32);
                    if (fq == 0) fx_add(ssq_out + grow0 + ai * 128 + m * 16, part); } }
        }
    }
};

__device__ __forceinline__ int map_row(int mk, int n) {
    if (mk == 1) return (n >> 7) * 256 + (n & 127);
    if (mk == 2) return (n >> 7) * 256 + 128 + (n & 127);
    if (mk == 3) return n < 1024 ? n : (n < 1088 ? n + 3072 : n - 64);
    return n;
}
__device__ __forceinline__ void conv_set(const Params& p, LAS unsigned char* lds, unsigned char* ws, int m_lo, int m_hi) {
    const int tid = tid_opaque();
    LAS float* sm = (LAS float*)lds;
    for (int mi = m_lo; mi < m_hi; ++mi) {
        int isrc, ign = -1, K, N, mk = 0; size_t soff = 0, goff = 0, doff;
        if (mi < 12) { const int f = mi / 3, w = mi % 3, slot = f;
            if (w == 0) { isrc = I_WG; soff = (size_t)f * DM * DFF; K = DM; N = DFF; doff = OFF_WGU + slot * SZ_WGU; mk = 1; ign = I_FNORM; goff = f * DM; }
            else if (w == 1) { isrc = I_WU; soff = (size_t)f * DM * DFF; K = DM; N = DFF; doff = OFF_WGU + slot * SZ_WGU; mk = 2; ign = I_FNORM; goff = f * DM; }
            else { isrc = I_WDN; soff = (size_t)f * DFF * DM; K = DFF; N = DM; doff = OFF_WD + slot * SZ_WD; } }
        else if (mi == 12) { isrc = I_ABIN; K = DM; N = 4160; doff = OFF_WIN0; mk = 3; ign = I_MNORM; }
        else if (mi == 13) { isrc = I_WQB; K = 512; N = 1536; doff = OFF_WQB; ign = I_QANORM; }
        else if (mi == 14) { isrc = I_WKVB; K = 512; N = 2048; doff = OFF_WKVB; ign = I_KVANORM; }
        else if (mi == 15) { isrc = I_ABOUT; K = DM; N = DM; doff = OFF_WOUT0; }
        else if (mi == 16) { isrc = I_CIN; K = DM; N = 3072; doff = OFF_WIN1; ign = I_MNORM; goff = DM; }
        else { isrc = I_COUT; K = DM; N = DM; doff = OFF_WOUT1; }
        const float* src = p.in[isrc] + soff; const float* gain = ign >= 0 ? p.in[ign] + goff : nullptr; bf16_t* dst = (bf16_t*)(ws + doff);
        const int tn = N >> 6, tk = K >> 8, nt = tn * tk;
        f32x4 v[8], vn[8];
        int t = blockIdx.x;
        if (t < nt) { const int k0 = (t / tn) << 8, n0 = (t % tn) << 6;
#pragma unroll
            for (int i = 0; i < 8; ++i) { const int r = (tid >> 4) + 32 * i, c4 = tid & 15; v[i] = *(const f32x4*)(src + (size_t)(k0 + r) * N + n0 + 4 * c4); } }
        for (; t < nt; t += gridDim.x) {
            const int k0 = (t / tn) << 8, n0 = (t % tn) << 6;
            f32x4 gv[8];
            if (gain) {
#pragma unroll
                for (int i = 0; i < 4; ++i) { const int kc = ((tid >> 3) & 7) | (i << 3); gv[2 * i] = *(const f32x4*)(gain + k0 + kc * 8); gv[2 * i + 1] = *(const f32x4*)(gain + k0 + kc * 8 + 4); } }
            const int t2 = t + gridDim.x;
            if (t2 < nt) { const int k2 = (t2 / tn) << 8, n2 = (t2 % tn) << 6;
#pragma unroll
                for (int i = 0; i < 8; ++i) { const int r = (tid >> 4) + 32 * i, c4 = tid & 15; vn[i] = *(const f32x4*)(src + (size_t)(k2 + r) * N + n2 + 4 * c4); } }
#pragma unroll
            for (int i = 0; i < 8; ++i) { const int r = (tid >> 4) + 32 * i, c4 = tid & 15;
#pragma unroll
                for (int j = 0; j < 4; ++j) sm[r * 65 + 4 * c4 + j] = v[i][j]; }
            __syncthreads();
#pragma unroll
            for (int i = 0; i < 4; ++i) { const int q = tid + 512 * i, n = (q & 7) | (((q >> 6) & 7) << 3), kc = ((q >> 3) & 7) | ((q >> 9) << 3);
                float e[8];
#pragma unroll
                for (int j = 0; j < 8; ++j) e[j] = sm[(kc * 8 + j) * 65 + n];
                if (gain) {
#pragma unroll
                    for (int j = 0; j < 4; ++j) { e[j] *= gv[2 * i][j]; e[4 + j] *= gv[2 * i + 1][j]; } }
                u32x4 o = {pk2(e[0], e[1]), pk2(e[2], e[3]), pk2(e[4], e[5]), pk2(e[6], e[7])};
                *(u32x4*)(dst + (size_t)map_row(mk, n0 + n) * K + k0 + kc * 8) = o; }
            __syncthreads();
#pragma unroll
            for (int i = 0; i < 8; ++i) v[i] = vn[i];
        }
    }
}
__device__ __forceinline__ void init_phase(const Params& p, LAS unsigned char* lds, unsigned char* ws) {
    conv_set(p, lds, ws, 0, 18);
    const int tid = tid_opaque();
    const int gt = blockIdx.x * NTHR + tid, gn = gridDim.x * NTHR;
    { u32x4* z = (u32x4*)(ws + OFF_WIN0 + (size_t)4160 * DM * 2); const int n16 = 192 * DM * 2 / 16; const u32x4 zero = {0u, 0u, 0u, 0u};
      for (int i = gt; i < n16; i += gn) z[i] = zero;
      u32x4* q = (u32x4*)(ws + OFF_SSQ + (size_t)MTOT * 4); const int m16 = 7 * MTOT * 4 / 16;
      for (int i = gt; i < m16; i += gn) q[i] = zero; }
    { float* c32 = (float*)(ws + OFF_ROPE32); float* s32 = c32 + SEQ * 32; float* c64 = (float*)(ws + OFF_ROPE64); float* s64 = c64 + SEQ * 64;
      for (int i = gt; i < SEQ * 32; i += gn) { const int pos = i >> 5, j = i & 31; const float inv = 1.0f / powf(10000.0f, (float)(2 * j) / 64.0f); const float ang = (float)pos * inv;
          const double a = (double)ang; const double kk = rint(a * 0.15915494309189535); const float rr = (float)(a - kk * 6.283185307179586);
          c32[i] = cosf(rr); s32[i] = sinf(rr); }
      for (int i = gt; i < SEQ * 64; i += gn) { const int pos = i >> 6, j = i & 63; const float inv = 1.0f / powf(10000.0f, (float)(2 * j) / 128.0f); const float ang = (float)pos * inv;
          const double a = (double)ang; const double kk = rint(a * 0.15915494309189535); const float rr = (float)(a - kk * 6.283185307179586);
          c64[i] = cosf(rr); s64[i] = sinf(rr); } }
    { const int lane = tid & 63, wave = tid >> 6;
      bf16_t* XB = (bf16_t*)(ws + OFF_XB); float* SSQ0 = (float*)(ws + OFF_SSQ);
      for (int r = blockIdx.x * 8 + wave; r < MTOT; r += gridDim.x * 8) {
        const float* xr = r < NPROMPT ? p.in[I_XP] + (size_t)r * DM : p.in[I_XS] + (size_t)(r - NPROMPT) * DM;
        f32x4 v[8]; float ss = 0.f;
#pragma unroll
        for (int i = 0; i < 8; ++i) { v[i] = *(const f32x4*)(xr + lane * 4 + 256 * i); ss += v[i][0] * v[i][0] + v[i][1] * v[i][1] + v[i][2] * v[i][2] + v[i][3] * v[i][3]; }
        ss = wave_sum_l(ss, lane);
#pragma unroll
        for (int i = 0; i < 8; ++i) { u32x2 o = {pk2(v[i][0], v[i][1]), pk2(v[i][2], v[i][3])}; *(u32x2*)(XB + (size_t)r * DM + lane * 4 + 256 * i) = o; }
        if (lane == 0) ((unsigned*)SSQ0)[r] = (unsigned)(ss * FXS + 0.5f);
      } }
}

__device__ __forceinline__ void unpack8(const u32x4 u, float (&f)[8]) {
#pragma unroll
    for (int i = 0; i < 4; ++i) { f[2 * i] = bflo(u[i]); f[2 * i + 1] = bfhi(u[i]); }
}
__device__ __forceinline__ void mla_conv(const Params& p, unsigned char* ws) {
    const int tid = tid_opaque(), lane = tid & 63, wave = tid >> 6;
    const bf16_t* Z = (const bf16_t*)(ws + OFF_Z); bf16_t* ATT = (bf16_t*)(ws + OFF_ATT);
    const float* cw = p.in[I_CONVW] + lane * 16;
    for (int r = blockIdx.x * 8 + wave; r < MC; r += gridDim.x * 8) {
        const bf16_t* z = Z + (size_t)r * ZW0;
        const int t = r & (SEQ - 1);
#pragma unroll
        for (int hv = 0; hv < 2; ++hv) {
            const int c0 = lane * 16 + hv * 8;
            float gb[8], gc[8], uu[8], cu[8], acc[8];
            unpack8(*(const u32x4*)(z + 1024 + c0), gb);
            unpack8(*(const u32x4*)(z + 2048 + c0), gc); unpack8(*(const u32x4*)(z + 3072 + c0), uu);
            const f32x4 w1a = *(const f32x4*)(cw + 1024 + hv * 8), w1b = *(const f32x4*)(cw + 1024 + hv * 8 + 4);
#pragma unroll
            for (int j = 0; j < 8; ++j) { cu[j] = gc[j] * uu[j]; acc[j] = cu[j] * (j < 4 ? w1a[j] : w1b[j - 4]); }
            if (t > 0) { unpack8(*(const u32x4*)(z - ZW0 + 2048 + c0), gc); unpack8(*(const u32x4*)(z - ZW0 + 3072 + c0), uu);
                const f32x4 w0a = *(const f32x4*)(cw + hv * 8), w0b = *(const f32x4*)(cw + hv * 8 + 4);
#pragma unroll
                for (int j = 0; j < 8; ++j) acc[j] += gc[j] * uu[j] * (j < 4 ? w0a[j] : w0b[j - 4]); }
            if (t < SEQ - 1) { unpack8(*(const u32x4*)(z + ZW0 + 2048 + c0), gc); unpack8(*(const u32x4*)(z + ZW0 + 3072 + c0), uu);
                const f32x4 w2a = *(const f32x4*)(cw + 2048 + hv * 8), w2b = *(const f32x4*)(cw + 2048 + hv * 8 + 4);
#pragma unroll
                for (int j = 0; j < 8; ++j) acc[j] += gc[j] * uu[j] * (j < 4 ? w2a[j] : w2b[j - 4]); }
            u32x4 o = {pk2(gb[0] * acc[0], gb[1] * acc[1]), pk2(gb[2] * acc[2], gb[3] * acc[3]), pk2(gb[4] * acc[4], gb[5] * acc[5]), pk2(gb[6] * acc[6], gb[7] * acc[7])};
            *(u32x4*)(ATT + (size_t)r * DM + 1024 + c0) = o;
        }
    }
}
__device__ __forceinline__ void vt_transpose(LAS unsigned char* lds, const bf16_t* V, int ld, int coff, int hstride, int HK, bf16_t* VT) {
    const int tid = tid_opaque();
    LAS bf16_t* sm = (LAS bf16_t*)lds;
    const int ngrp = (MC / 256) * HK;
    for (int grp = blockIdx.x; grp < ngrp; grp += gridDim.x) {
        const int h = grp % HK, tb4 = grp / HK;
        const int row0 = tb4 * 256, seq = row0 / SEQ, t0 = row0 % SEQ;
        u32x4 v[8];
#pragma unroll
        for (int i = 0; i < 8; ++i) { const int q = tid + 512 * i, t = q & 255, dc = q >> 8;
            v[i] = *(const u32x4*)(V + (size_t)(row0 + t) * ld + coff + h * hstride + dc * 8); }
#pragma unroll
        for (int i = 0; i < 8; ++i) { const int q = tid + 512 * i, t = q & 255, dc = q >> 8; LAS bf16_t* d = sm + (t >> 6) * (128 * 72) + (t & 63);
#pragma unroll
            for (int j = 0; j < 4; ++j) { d[(dc * 8 + 2 * j) * 72] = (bf16_t)(v[i][j] & 0xffffu); d[(dc * 8 + 2 * j + 1) * 72] = (bf16_t)(v[i][j] >> 16); } }
        __syncthreads();
#pragma unroll
        for (int i = 0; i < 8; ++i) { const int q = tid + 512 * i, tc = q & 31, d = q >> 5;
            const u32x4 w = *(const LAS u32x4*)(sm + (tc >> 3) * (128 * 72) + d * 72 + (tc & 7) * 8);
            *(u32x4*)(VT + ((size_t)(seq * HK + h) * 128 + d) * SEQ + t0 + tc * 8) = w; }
        __syncthreads();
    }
}
__device__ __forceinline__ void ld8(const float* g, float (&o)[8]) { const f32x4 a = *(const f32x4*)g, b = *(const f32x4*)(g + 4);
#pragma unroll
    for (int j = 0; j < 4; ++j) { o[j] = a[j]; o[4 + j] = b[j]; } }
__device__ __forceinline__ u32x4 pack8(const float (&f)[8]) { u32x4 o = {pk2(f[0], f[1]), pk2(f[2], f[3]), pk2(f[4], f[5]), pk2(f[6], f[7])}; return o; }
__device__ __forceinline__ void mla_prep2(const Params& p, unsigned char* ws, LAS unsigned char* lds) {
    const int tid = tid_opaque(), lane = tid & 63, wave = tid >> 6;
    const bf16_t* Z = (const bf16_t*)(ws + OFF_Z); bf16_t* QR = (bf16_t*)(ws + OFF_QR); const bf16_t* KVR = (const bf16_t*)(ws + OFF_KVR); bf16_t* KF = (bf16_t*)(ws + OFF_KF);
    const float* c32 = (const float*)(ws + OFF_ROPE32); const float* s32 = c32 + SEQ * 32;
    const bool act = lane < 48; const int hsel = lane >= 24, li = act ? lane - hsel * 24 : 0, base = hsel * 24, l7 = li & 7;
    float qn[8], kn[8]; ld8(p.in[I_QNORM] + li * 8, qn); ld8(p.in[I_KNORM] + li * 8, kn);
    const bool isrope = li >= 16; const float sgn = li < 20 ? -1.f : 1.f;
    for (int r = blockIdx.x * 8 + wave; r < MC; r += gridDim.x * 8) {
        const int pos = r & (SEQ - 1);
        float cs[8], sn[8];
        if (isrope) { ld8(c32 + pos * 32 + (li & 3) * 8, cs); ld8(s32 + pos * 32 + (li & 3) * 8, sn); }
        u32x4 raw[8];
#pragma unroll
        for (int it = 0; it < 4; ++it) { const int head = it * 2 + hsel;
            raw[it] = *(const u32x4*)(QR + (size_t)r * 1536 + head * 192 + li * 8);
            raw[4 + it] = isrope ? *(const u32x4*)(Z + (size_t)r * ZW0 + 4096 + (li - 16) * 8) : *(const u32x4*)(KVR + (size_t)r * 2048 + head * 256 + li * 8); }
#pragma unroll
        for (int it = 0; it < 8; ++it) { const int head = (it & 3) * 2 + hsel; const bool isk = it >= 4;
            float f[8]; unpack8(raw[it], f);
            float ss = 0.f;
#pragma unroll
            for (int j = 0; j < 8; ++j) ss += f[j] * f[j];
            ss += shflx(ss, lane, 1); ss += shflx(ss, lane, 2); ss += shflx(ss, lane, 4);
            const float tot = __int_as_float(__builtin_amdgcn_ds_bpermute((base + l7) << 2, __float_as_int(ss))) + __int_as_float(__builtin_amdgcn_ds_bpermute((base + 8 + l7) << 2, __float_as_int(ss)))
                            + __int_as_float(__builtin_amdgcn_ds_bpermute((base + 16 + l7) << 2, __float_as_int(ss)));
            const float rs = rsqrtf(tot * (1.0f / 192.0f) + EPSN);
            float n[8], o[8];
#pragma unroll
            for (int j = 0; j < 8; ++j) n[j] = f[j] * rs * (isk ? kn[j] : qn[j]);
#pragma unroll
            for (int j = 0; j < 8; ++j) { const float pr = shflx(n[j], lane, 4); o[j] = isrope ? n[j] * cs[j] + sgn * pr * sn[j] : n[j]; }
            if (act) *(u32x4*)((isk ? KF : QR) + (size_t)r * 1536 + head * 192 + li * 8) = pack8(o);
        }
    }
    vt_transpose(lds, KVR, 2048, 128, 256, 8, (bf16_t*)(ws + OFF_VT));
    mla_conv(p, ws);
}
__device__ __forceinline__ void gqa_prep(const Params& p, unsigned char* ws, LAS unsigned char* lds) {
    const int tid = tid_opaque(), lane = tid & 63, wave = tid >> 6;
    const bf16_t* Z = (const bf16_t*)(ws + OFF_Z); bf16_t* Q1 = (bf16_t*)(ws + OFF_KVR); bf16_t* K1 = (bf16_t*)(ws + OFF_QA);
    const float* c64 = (const float*)(ws + OFF_ROPE64); const float* s64 = c64 + SEQ * 64;
    const int g4 = lane >> 4, li = lane & 15;
    float qn[8], kn[8]; ld8(p.in[I_CQN] + li * 8, qn); ld8(p.in[I_CKN] + li * 8, kn);
    const float sgn = li < 8 ? -1.f : 1.f;
    for (int r = blockIdx.x * 8 + wave; r < MC; r += gridDim.x * 8) {
        const int pos = r & (SEQ - 1);
        float cs[8], sn[8]; ld8(c64 + pos * 64 + (li & 7) * 8, cs); ld8(s64 + pos * 64 + (li & 7) * 8, sn);
        u32x4 raw[5];
#pragma unroll
        for (int it = 0; it < 5; ++it) raw[it] = *(const u32x4*)(Z + (size_t)r * ZW1 + (it * 4 + g4) * 128 + li * 8);
#pragma unroll
        for (int it = 0; it < 5; ++it) { const int head = it * 4 + g4; const bool isk = it == 4;
            float f[8]; unpack8(raw[it], f);
            float ss = 0.f;
#pragma unroll
            for (int j = 0; j < 8; ++j) ss += f[j] * f[j];
            ss += shflx(ss, lane, 1); ss += shflx(ss, lane, 2); ss += shflx(ss, lane, 4); ss += shflx(ss, lane, 8);
            const float rs = rsqrtf(ss * (1.0f / 128.0f) + EPSN);
            float n[8], o[8];
#pragma unroll
            for (int j = 0; j < 8; ++j) n[j] = f[j] * rs * (isk ? kn[j] : qn[j]);
#pragma unroll
            for (int j = 0; j < 8; ++j) { const float pr = shflx(n[j], lane, 8); o[j] = n[j] * cs[j] + sgn * pr * sn[j]; }
            bf16_t* op = isk ? K1 + (size_t)r * 512 + g4 * 128 + li * 8 : Q1 + (size_t)r * 2048 + head * 128 + li * 8;
            *(u32x4*)op = pack8(o);
        }
    }
    vt_transpose(lds, Z, ZW1, 2560, 128, 4, (bf16_t*)(ws + OFF_VT));
}

template <int DQK, bool WIN>
__device__ __forceinline__ void attn_phase(LAS unsigned char* lds, const bf16_t* __restrict__ Q, int ldq, const bf16_t* __restrict__ K, int ldk,
                                           const bf16_t* __restrict__ VT, bf16_t* __restrict__ O, int HQ, int HK, const float* __restrict__ sink, float cscale) {
    constexpr int KS = DQK * 2 + 16, VS = 144, KB = 64 * KS, VB = 128 * VS, BUF = KB + VB, NKS = DQK / 16, KCH = DQK / 8, NKL = 64 * KCH / 512;
    static_assert(3 * BUF <= LDS_STAGE, "lds");
    const int tid = tid_opaque(), lane = tid & 63, wave = __builtin_amdgcn_readfirstlane(tid >> 6), l31 = lane & 31, hh = lane >> 5;
    const bool grpB = wave >= 4;
    const int pi = (l31 & 0x13) | ((l31 & 4) << 1) | ((l31 & 8) >> 1);
    const int G = HQ / HK, nitems = SPC * HQ * 16;
    const int G_ = gridDim.x, b_ = blockIdx.x, vb = (G_ & 7) == 0 ? (b_ & 7) * (G_ >> 3) + (b_ >> 3) : b_;
    for (int it = vb; it < nitems; it += gridDim.x) {
        const int qb = it & 15, head = (it >> 4) % HQ, seq = it / (16 * HQ), hk = head / G;
        const int q0 = qb * 256, wq0 = q0 + wave * 32, qrow = wq0 + l31;
        bf16x8 qf[NKS];
        { const bf16_t __attribute__((address_space(1)))* qp = (const bf16_t __attribute__((address_space(1)))*)Q + (size_t)(seq * SEQ + qrow) * ldq + head * DQK + hh * 8;
#pragma unroll
          for (int ks = 0; ks < NKS; ++ks) qf[ks] = *(const bf16x8 __attribute__((address_space(1)))*)(qp + ks * 16); }
        int kt_lo = 0, kt_hi = SEQ / 64;
        if (WIN) { kt_lo = (q0 - 128 > 0 ? q0 - 128 : 0) >> 6; kt_hi = (q0 + 384 < SEQ ? q0 + 384 : SEQ) >> 6; }
        const bf16_t __attribute__((address_space(1)))* kbase = (const bf16_t __attribute__((address_space(1)))*)K + (size_t)(seq * SEQ) * ldk + hk * DQK;
        const bf16_t __attribute__((address_space(1)))* vbase = (const bf16_t __attribute__((address_space(1)))*)VT + (size_t)((seq * HK + hk) * 128) * SEQ;
        f32x16 o[4];
#pragma unroll
        for (int db = 0; db < 4; ++db)
#pragma unroll
            for (int i = 0; i < 16; ++i) o[db][i] = 0.f;
        float m = WIN ? sink[head] * LOG2E / cscale : -1e30f;
        float lsum = (WIN && hh == 0) ? 1.f : 0.f;
        u32x4 kreg[NKL], vreg[2];
        unsigned koff[NKL], voff[2];
#pragma unroll
        for (int i_ = 0; i_ < NKL; ++i_) { const int ch_ = tid + 512 * i_, row_ = ch_ / KCH, cc_ = ch_ % KCH; koff[i_] = (unsigned)(row_ * ldk + cc_ * 8) * 2u; }
#pragma unroll
        for (int i_ = 0; i_ < 2; ++i_) { const int ch_ = tid + 512 * i_, row_ = ch_ >> 3, cc_ = ch_ & 7; voff[i_] = (unsigned)(row_ * SEQ + cc_ * 8) * 2u; }
#define ATT_GLOAD(kt_) do { \
            const char __attribute__((address_space(1)))* kt_b = (const char __attribute__((address_space(1)))*)kbase + (size_t)(kt_) * 64 * ldk * 2; \
            const char __attribute__((address_space(1)))* vt_b = (const char __attribute__((address_space(1)))*)vbase + (size_t)(kt_) * 128; \
            _Pragma("unroll") for (int i_ = 0; i_ < NKL; ++i_) kreg[i_] = *(const u32x4 __attribute__((address_space(1)))*)(kt_b + koff[i_]); \
            _Pragma("unroll") for (int i_ = 0; i_ < 2; ++i_) vreg[i_] = *(const u32x4 __attribute__((address_space(1)))*)(vt_b + voff[i_]); } while (0)
#define ATT_LSTORE(b_) do { \
            _Pragma("unroll") for (int i_ = 0; i_ < NKL; ++i_) { const int ch_ = tid + 512 * i_, row_ = ch_ / KCH, cc_ = ch_ % KCH; *(LAS u32x4*)(lds + (b_) * BUF + row_ * KS + cc_ * 16) = kreg[i_]; } \
            _Pragma("unroll") for (int i_ = 0; i_ < 2; ++i_) { const int ch_ = tid + 512 * i_, row_ = ch_ >> 3, cc_ = ch_ & 7; *(LAS u32x4*)(lds + (b_) * BUF + KB + row_ * VS + cc_ * 16) = vreg[i_]; } } while (0)
        ATT_GLOAD(kt_lo); ATT_LSTORE(0); __syncthreads();
        for (int kt = kt_lo; kt < kt_hi; ++kt) {
            const int cur = (kt - kt_lo) & 1;
            const bool more = kt + 1 < kt_hi;
            if (more) ATT_GLOAD(kt + 1);
            bool need = true;
            if (WIN) need = (kt * 64 + 63 >= wq0 - 128) && (kt * 64 <= wq0 + 31 + 128);
            if (need) {
                LAS unsigned char* kb_ = lds + cur * BUF; LAS unsigned char* vb_ = kb_ + KB;
                f32x16 s[2];
#pragma unroll
                for (int kb2 = 0; kb2 < 2; ++kb2)
#pragma unroll
                    for (int i = 0; i < 16; ++i) s[kb2][i] = 0.f;
                constexpr int KG = DQK == 128 ? 4 : 2;
#pragma unroll
                for (int g4 = 0; g4 < NKS / KG; ++g4) {
                    bf16x8 ka[2][KG];
#pragma unroll
                    for (int k = 0; k < KG; ++k)
#pragma unroll
                        for (int kb2 = 0; kb2 < 2; ++kb2) ka[kb2][k] = *(const LAS bf16x8*)(kb_ + (kb2 * 32 + pi) * KS + (g4 * KG + k) * 32 + hh * 16);
                    __builtin_amdgcn_sched_barrier(0);
#pragma unroll
                    for (int k = 0; k < KG; ++k)
#pragma unroll
                        for (int kb2 = 0; kb2 < 2; ++kb2) s[kb2] = __builtin_amdgcn_mfma_f32_32x32x16_bf16(ka[kb2][k], qf[g4 * KG + k], s[kb2], 0, 0, 0);
                    __builtin_amdgcn_sched_barrier(0);
                }
                float mx = -1e30f;
#pragma unroll
                for (int kb2 = 0; kb2 < 2; ++kb2)
#pragma unroll
                    for (int ii = 0; ii < 16; ++ii) { float t = s[kb2][ii];
                        if (WIN) { const int kp = kt * 64 + kb2 * 32 + 16 * (ii >> 3) + 8 * hh + (ii & 7); const int d = qrow - kp; t = (d <= 128 && d >= -128) ? t : -1e30f; s[kb2][ii] = t; }
                        mx = fmaxf(mx, t); }
                mx = fmaxf(mx, shflx(mx, lane, 32));
                const bool moved = __builtin_amdgcn_ballot_w64((mx - m) * cscale > 8.0f) != 0ull;
                const float mn = moved ? fmaxf(m, mx) : m;
                const float mnc = -mn * cscale;
                if (moved) { const float alpha = __builtin_amdgcn_exp2f((m - mn) * cscale); m = mn; lsum *= alpha;
#pragma unroll
                    for (int db = 0; db < 4; ++db)
#pragma unroll
                        for (int i = 0; i < 16; ++i) o[db][i] *= alpha; }
                float ps = 0.f;
#define ATT_P8(j_) do { const int kb_p = (j_) >> 1, b_p = ((j_) & 1) * 8; \
                    _Pragma("unroll") for (int e_ = 0; e_ < 8; ++e_) { const float pv = __builtin_amdgcn_exp2f(fmaf(s[kb_p][b_p + e_], cscale, mnc)); s[kb_p][b_p + e_] = pv; ps += pv; } } while (0)
                ATT_P8(0);
#pragma unroll
                for (int j = 0; j < 4; ++j) { const int kb2 = j >> 1, b8 = (j & 1) * 8; __builtin_amdgcn_sched_barrier(0);
                    bf16x8 va[4];
#pragma unroll
                    for (int db = 0; db < 4; ++db) va[db] = *(const LAS bf16x8*)(vb_ + (db * 32 + l31) * VS + (16 * j + 8 * hh) * 2);
                    u32x4 pb = {pk2(s[kb2][b8], s[kb2][b8 + 1]), pk2(s[kb2][b8 + 2], s[kb2][b8 + 3]), pk2(s[kb2][b8 + 4], s[kb2][b8 + 5]), pk2(s[kb2][b8 + 6], s[kb2][b8 + 7])};
                    const bf16x8 bfrag = __builtin_bit_cast(bf16x8, pb);
                    __builtin_amdgcn_sched_barrier(0);
#pragma unroll
                    for (int db = 0; db < 4; ++db) o[db] = __builtin_amdgcn_mfma_f32_32x32x16_bf16(va[db], bfrag, o[db], 0, 0, 0);
                    if (j < 3) ATT_P8(j + 1); }
#undef ATT_P8
                lsum += ps;
            }
            if (more) ATT_LSTORE(cur ^ 1);
            __syncthreads();
        }
#undef ATT_GLOAD
#undef ATT_LSTORE
        const float l = lsum + shflx(lsum, lane, 32); const float inv = 1.0f / l;
        bf16_t __attribute__((address_space(1)))* op = (bf16_t __attribute__((address_space(1)))*)O + (size_t)(seq * SEQ + qrow) * DM + head * 128 + 4 * hh;
#pragma unroll
        for (int db = 0; db < 4; ++db)
#pragma unroll
            for (int g = 0; g < 4; ++g) { u32x2 w = {pk2(o[db][4 * g] * inv, o[db][4 * g + 1] * inv), pk2(o[db][4 * g + 2] * inv, o[db][4 * g + 3] * inv)};
                *(u32x2 __attribute__((address_space(1)))*)(op + db * 32 + 8 * g) = w; }
    }
}

#define XB_TMO      128
#define XB_XCNT(j)  (256  + 64 * (j))
#define XB_XSUB(j)  (1280 + 64 * (j))
#define XB_XGEN(j)  (2304 + 64 * (j))
#define XB_TOP      3328
#define XB_TOPGEN   3392
#define XCD_BAR_WORDS 3456
#define XB_SPIN_CAP (1u << 18)

__device__ __forceinline__ unsigned xb_ld(unsigned* p)              { return __hip_atomic_load(p, __ATOMIC_RELAXED, __HIP_MEMORY_SCOPE_AGENT); }
__device__ __forceinline__ unsigned xb_add(unsigned* p, unsigned v) { return __hip_atomic_fetch_add(p, v, __ATOMIC_RELAXED, __HIP_MEMORY_SCOPE_AGENT); }
__device__ __forceinline__ unsigned xb_xcc_id() { return (unsigned)__builtin_amdgcn_s_getreg((3 << 11) | 20) & 0xFu; }
#define XB_SPIN(cond, bar) do { unsigned _sp = 0; while (cond) { __builtin_amdgcn_s_sleep(1); \
    if ((++_sp & 255u) == 0u) { if (xb_ld(&(bar)[XB_TMO])) break; if (_sp > XB_SPIN_CAP) { atomicAdd(&(bar)[XB_TMO], 1u); break; } } } } while (0)

struct XcdBarrier {
    unsigned* bar; unsigned x;
    volatile LAS unsigned* st;
};

__device__ __forceinline__ XcdBarrier xcd_barrier_post(unsigned* bar, volatile LAS unsigned* st) {
    XcdBarrier b; b.bar = bar; b.x = xb_xcc_id(); b.st = st;
    if (threadIdx.x == 0) (void)xb_add(&bar[XB_XCNT(b.x)], 1u);
    return b;
}
__device__ __forceinline__ void xcd_barrier_complete(unsigned* bar, unsigned x, unsigned& nloc, unsigned& nx) {
    const unsigned G = gridDim.x * gridDim.y * gridDim.z;
    unsigned sum, cnt, mine, sp = 0u;
    for (;;) {
        sum = 0u; cnt = 0u; mine = 0u;
#pragma unroll
        for (unsigned j = 0; j < 16; ++j) { const unsigned c = xb_ld(&bar[XB_XCNT(j)]); sum += c; cnt += (c > 0u) ? 1u : 0u; mine = (j == x) ? c : mine; }
        if (sum == G) break;
        __builtin_amdgcn_s_sleep(1);
        if ((++sp & 255u) == 0u) { if (xb_ld(&bar[XB_TMO])) break; if (sp > XB_SPIN_CAP) { atomicAdd(&bar[XB_TMO], 1u); break; } }
    }
    nloc = mine > 0u ? mine : 1u; nx = cnt > 0u ? cnt : 1u;
}

__device__ __forceinline__ void xcd_barrier(const XcdBarrier& b) {
    asm volatile("s_waitcnt vmcnt(0)" ::: "memory");
    __syncthreads();
    if (threadIdx.x == 0) {
        unsigned* bar = b.bar;
        __builtin_amdgcn_s_waitcnt(0);
        unsigned nloc = b.st[0], nx = b.st[1];
        if (nloc == 0u) { xcd_barrier_complete(bar, b.x, nloc, nx); b.st[0] = nloc; b.st[1] = nx; }
        const unsigned old = xb_add(&bar[XB_XSUB(b.x)], 1u);
        const unsigned gen = old / nloc;
        if (old + 1u == (gen + 1u) * nloc) {
            __builtin_amdgcn_fence(__ATOMIC_RELEASE, "agent");
            asm volatile("s_waitcnt vmcnt(0)" ::: "memory");
            const unsigned og = xb_add(&bar[XB_TOP], 1u);
            const unsigned tg = og / nx;
            if (og + 1u == (tg + 1u) * nx) xb_add(&bar[XB_TOPGEN], 1u);
            else XB_SPIN(xb_ld(&bar[XB_TOPGEN]) == tg, bar);
            __builtin_amdgcn_fence(__ATOMIC_ACQUIRE, "agent");
            xb_add(&bar[XB_XGEN(b.x)], 1u);
            asm volatile("s_waitcnt vmcnt(0)" ::: "memory");
        } else {
            XB_SPIN(xb_ld(&bar[XB_XGEN(b.x)]) == gen, bar);
            __builtin_amdgcn_fence(__ATOMIC_ACQUIRE, "agent");
            asm volatile("s_waitcnt vmcnt(0)" ::: "memory");
        }
    }
    __syncthreads();
}


struct EpiAny {
    static constexpr bool AFTER_DRAIN = false;
    int mode; EpiStoreBf16 e0; EpiSwiglu e1; EpiResid e2; mutable float prev[8];
    __device__ __forceinline__ bool perm() const { return true; }
    __device__ __forceinline__ void pre(const pg8::Unit& u, int wr, int fr, int tid) const {
        if (mode != 2 && e0.ssq) { const float __attribute__((address_space(1)))* sp = (const float __attribute__((address_space(1)))*)e0.ssq + u.pm * 256 + wr * 64 + fr;
#pragma unroll
            for (int j = 0; j < 8; ++j) prev[j] = sp[(j >> 2) * 128 + (j & 3) * 16]; }
    }
    __device__ __forceinline__ void operator()(const f32x4 (&acc)[2][2][4][2], const pg8::Unit& u, int wr, int wc, int fr, int fq) const {
        if (mode == 0) e0(acc, u, wr, wc, fr, fq, prev); else if (mode == 1) e1(acc, u, wr, wc, fr, fq, prev); else e2(acc, u, wr, wc, fr, fq);
    }
};
constexpr int PPC = 17, NPHASE = 1 + NCH * PPC;
enum { K_GU = 0, K_DOWN, K_INPROJ, K_PREP1, K_QKVB, K_PREP2, K_ATTN, K_OUT };
__device__ __forceinline__ void run_phase(const Params& p, int ph, LAS unsigned char* lds) {
    unsigned char* ws = p.ws; OPAQUE(ws);
    const int q = ph - 1, chunk = q / PPC, r = q % PPC, layer = r >= 9, sidx = layer ? r - 9 : r;
    int kind, f = 0;
    if (sidx < 2) kind = sidx;
    else if (layer == 0) { if (sidx == 2) kind = K_INPROJ; else if (sidx < 7) kind = sidx + 1; else { kind = sidx - 7; f = 1; } }
    else { if (sidx == 2) kind = K_INPROJ; else if (sidx == 3) kind = K_PREP1; else if (sidx == 4) kind = K_ATTN; else if (sidx == 5) kind = K_OUT; else { kind = sidx - 6; f = 1; } }
    if (kind == K_PREP1) {
        for (int rep = 0; rep < REP_PREP; ++rep) gqa_prep(p, ws, lds);
        return; }
    if (kind == K_PREP2) { mla_prep2(p, ws, lds); return; }
    if (kind == K_ATTN) {
        for (int rep = 0; rep < REP_ATT; ++rep)
        if (layer == 0) attn_phase<192, false>(lds, (const bf16_t*)(ws + OFF_QR), 1536, (const bf16_t*)(ws + OFF_KF), 1536, (const bf16_t*)(ws + OFF_VT), (bf16_t*)(ws + OFF_ATT), 8, 8, nullptr, 0.07216878364870322f * LOG2E);
        else attn_phase<128, true>(lds, (const bf16_t*)(ws + OFF_KVR), 2048, (const bf16_t*)(ws + OFF_QA), 512, (const bf16_t*)(ws + OFF_VT), (bf16_t*)(ws + OFF_ATT), 16, 4, p.in[I_CSINK], 0.08838834764831845f * LOG2E);
        return; }
    const int njobs = kind == K_QKVB ? 2 : 1;
    const int nf = layer * 2 + f, slot = nf;
    for (int w = 0; w < njobs; ++w) {
        size_t offA, offB, offO = 0; int M = MC, N, K, lda = 0, mode, ldc = 0, ssq_in = -1, ssq_out = -1, row_base = chunk * MC; float scale = 1.0f, inv_n = 1.0f / DM; bool fi = false; bool sq2 = false;
        if (kind == K_GU) { offA = OFF_XB + (size_t)chunk * MC * DM * 2; offB = OFF_WGU + slot * SZ_WGU; N = 2 * DFF; K = DM; mode = 1; offO = OFF_H; ldc = DFF; ssq_in = nf == 0 ? 0 : (nf == 1 ? 2 : (nf == 2 ? 3 : 5)); }
        else if (kind == K_DOWN) { offA = OFF_H; offB = OFF_WD + slot * SZ_WD; N = DM; K = DFF; mode = 2; scale = 0.5f; fi = nf == 0; ssq_out = nf == 0 ? 1 : (nf == 1 ? 3 : (nf == 2 ? 4 : -1)); }
        else if (kind == K_INPROJ) { offA = OFF_XB + (size_t)chunk * MC * DM * 2; offB = layer ? OFF_WIN1 : OFF_WIN0; N = layer ? ZW1 : ZW0; K = DM; mode = 0; offO = OFF_Z; ldc = N; ssq_in = layer ? 4 : 1; sq2 = layer == 0; }
        else if (kind == K_QKVB) { offA = OFF_Z + (w ? 1024 : 0); lda = ZW0; offB = w ? OFF_WKVB : OFF_WQB; N = w ? 2048 : 1536; K = 512; mode = 0; offO = w ? OFF_KVR : OFF_QR; ldc = N; ssq_in = 6 + w; inv_n = 1.0f / 512.0f; }
        else { offA = OFF_ATT; offB = layer ? OFF_WOUT1 : OFF_WOUT0; N = DM; K = DM; mode = 2; ssq_out = layer ? 5 : 2; }
        if (lda == 0) lda = K;
        EpiAny E; E.mode = mode;
#pragma unroll
        for (int j = 0; j < 8; ++j) E.prev[j] = 1.0f;
        const float* ssqi = ssq_in >= 0 ? (const float*)(ws + OFF_SSQ) + (size_t)ssq_in * MTOT + row_base : nullptr;
        E.e0.O = (bf16_t*)(ws + offO); E.e0.ldc = ldc; E.e0.ssq = ssqi; E.e0.inv_n = inv_n; E.e0.sq2 = sq2 ? (float*)(ws + OFF_SSQ2) + row_base : nullptr;
        E.e1.H = (bf16_t*)(ws + offO); E.e1.ldc = ldc; E.e1.ssq = ssqi; E.e1.pad_ = 0;
        const float* xp = p.in[I_XP]; const float* xs = p.in[I_XS]; OPAQUE(xp); OPAQUE(xs);
        E.e2.dst = ssq_out >= 0 ? nullptr : p.out; E.e2.src0 = xp; E.e2.src1 = xs; E.e2.split_row = NPROMPT; E.e2.row_base = row_base; E.e2.scale = scale; E.e2.fi = fi ? 1 : 0;
        E.e2.xb = (bf16_t*)(ws + OFF_XB); E.e2.ssq_out = ssq_out >= 0 ? (float*)(ws + OFF_SSQ) + (size_t)ssq_out * MTOT : nullptr;
#if PREFETCH_B
        {
            const int tid_ = tid_opaque(); const u32x4* wp = (const u32x4*)(ws + offB); const int n16 = (int)(((size_t)N * K * 2) >> 4);
            unsigned acc_ = 0u;
            for (int i = blockIdx.x * NTHR + tid_; i < (n16 >> 3); i += gridDim.x * NTHR) { const u32x4 v_ = wp[(size_t)i * 8]; acc_ ^= v_[0]; }
            if (acc_ == 0x9e3779b9u && N == 7) ((unsigned*)(ws + OFF_BAR))[200] = acc_;
        }
#endif
        pg8::Gemm g; g.A = (const bf16_t*)(ws + offA); g.Bt = (const bf16_t*)(ws + offB); g.M = M; g.N = N; g.K = K; g.lda = lda;
        pg8::StaticOrder S; S.init(M, N, (int)gridDim.x, (int)blockIdx.x);
        if (mode == 2) S.wgm = WGM_RES;
        if (mode == 1) S.wgm = WGM_GU;
        pg8::gemm_phase<EpiAny, pg8::StaticOrder, false>(lds, g, S, E, nullptr);
    }
}
__global__ void __launch_bounds__(NTHR, 2) mega(Params p) {
    extern __shared__ __attribute__((aligned(16))) unsigned char smem[];
    LAS unsigned char* lds = (LAS unsigned char*)smem;
    cg::grid_group grid = cg::this_grid();
    volatile LAS unsigned* st = (volatile LAS unsigned*)(lds + LDS_STAGE);
    if (threadIdx.x < 4) st[threadIdx.x] = 0u;
    __syncthreads();
    XcdBarrier bar = xcd_barrier_post((unsigned*)(p.ws + OFF_BAR), st);
    int ph0 = p.ph_lo;
    if (ph0 == 0) {
        unsigned char* ws = p.ws; OPAQUE(ws);
        for (int rep = 0; rep < REP_INIT; ++rep) init_phase(p, lds, ws);
        if (p.ph_hi < 0) grid.sync();
        if (p.ph_hi > 1) xcd_barrier(bar);
        for (int i = 0; i < REP_SYNC; ++i) xcd_barrier(bar);
        ph0 = 1;
    }
    for (int ph = ph0; ph < p.ph_hi; ++ph) {
        run_phase(p, ph, lds);
        if (ph + 1 < p.ph_hi) xcd_barrier(bar);
    }
}

extern "C" void kernel_launch(void* const* d_in, const int* in_sizes, int n_in, void* d_out, int out_size, void* d_ws, size_t ws_size, hipStream_t stream) {
    static int grid = 0;
    if (grid == 0) {
        if (n_in != 21 || ws_size < WS_END || out_size != MTOT * DM) { fprintf(stderr, "kernel_launch: unexpected shapes (n_in %d, ws %zu need %zu, out %d)\n", n_in, ws_size, (size_t)WS_END, out_size); grid = -1; return; }
        int dev = 0, cus = 0, per_cu = 0;
        hipGetDevice(&dev);
        hipDeviceGetAttribute(&cus, hipDeviceAttributeMultiprocessorCount, dev);
        if (hipFuncSetAttribute((const void*)mega, hipFuncAttributeMaxDynamicSharedMemorySize, LDS_BYTES) != hipSuccess) { fprintf(stderr, "kernel_launch: hipFuncSetAttribute failed\n"); grid = -1; return; }
        if (hipOccupancyMaxActiveBlocksPerMultiprocessor(&per_cu, (const void*)mega, NTHR, LDS_BYTES) != hipSuccess || per_cu < 1) { fprintf(stderr, "kernel_launch: occupancy query says %d\n", per_cu); per_cu = 1; }
        (void)hipGetLastError();
        grid = cus * per_cu;
    }
    if (grid < 0) return;
    Params p{};
    for (int i = 0; i < 21; ++i) p.in[i] = (const float*)d_in[i];
    p.out = (float*)d_out; p.ws = (unsigned char*)d_ws;
#if ONE_LAUNCH
    if (hipMemsetAsync((unsigned char*)d_ws + OFF_BAR, 0, BAR_BYTES, stream) != hipSuccess) fprintf(stderr, "kernel_launch: memset failed\n");
    p.ph_lo = 0; p.ph_hi = NPHASE;
    void* args[] = {&p};
    hipError_t e = hipLaunchCooperativeKernel((const void*)mega, dim3(grid), dim3(NTHR), args, LDS_BYTES, stream);
    if (e != hipSuccess) fprintf(stderr, "kernel_launch: cooperative launch failed: %s (grid %d)\n", hipGetErrorString(e), grid);
#else
    for (int ph = 0; ph < NPHASE; ++ph) {
        p.ph_lo = ph; p.ph_hi = ph + 1;
        hipLaunchKernelGGL(mega, dim3(grid), dim3(NTHR), LDS_BYTES, stream, p);
    }
#endif
}
```

```cpp
#include <hip/hip_runtime.h>
#include <hip/hip_cooperative_groups.h>
#include <cstdio>
namespace cg = cooperative_groups;
#ifndef ONE_LAUNCH
#define ONE_LAUNCH 1
#endif
#ifndef PHM
#define PHM 63
#endif
#ifndef REP_ATT
#define REP_ATT 1
#endif
#ifndef REP_GU
#define REP_GU 1
#endif
#ifndef REP_NORM
#define REP_NORM 1
#endif
#ifndef REP_SYNC
#define REP_SYNC 0
#endif
#ifndef REP_INIT
#define REP_INIT 1
#endif
#ifndef REP_PREP
#define REP_PREP 1
#endif
#ifndef REP_M0
#define REP_M0 1
#endif
#ifndef REP_RES
#define REP_RES 1
#endif
#ifndef WGM_RES
#define WGM_RES 4
#endif
#ifndef PREFETCH_B
#define PREFETCH_B 0
#endif
#ifndef WGM_GU
#define WGM_GU 8
#endif
#ifndef REV_GU
#define REV_GU 0
#endif
#ifndef WGM_M0
#define WGM_M0 4
#endif
#ifndef RESID_FROM_XB
#define RESID_FROM_XB 1
#endif
namespace pg8 {
#define PG8_LAS __attribute__((address_space(3)))
typedef unsigned short bf16_t;
typedef short bf16x8 __attribute__((ext_vector_type(8)));
typedef float f32x4 __attribute__((ext_vector_type(4)));
typedef unsigned u32x4 __attribute__((ext_vector_type(4)));
constexpr int BM = 256, BK = 64, HALF = 128, HTB = HALF * BK * 2  , STAGE_BYTES = 8 * HTB, NXCD = 8, WGM = 8;

__host__ __device__ __forceinline__ int lds_byte(int r, int c) { const int st = (r >> 4) * 2 + (c >> 5), rr = r & 15, cc = c & 31, ob = rr * 64 + cc * 2; return st * 1024 + (ob ^ (((ob >> 9) & 1) << 5)); }
__host__ __device__ __forceinline__ void stage_rc(int b, int& R, int& C) { const int st = b / 1024, sb = b % 1024, swz = sb ^ (((sb >> 9) & 1) << 5); R = (st >> 1) * 16 + swz / 64; C = (st & 1) * 32 + (swz % 64) / 2; }
__host__ __device__ __forceinline__ int perm32(int rho) { const int n = rho >> 4, i = rho & 15; return 8 * (i >> 2) + 4 * n + (i & 3); }

struct Unit { int pm, pn; };
struct Gemm { const bf16_t* A; const bf16_t* Bt; int M, N, K, lda; };

struct StaticOrder {
    int nM, nN, nwg, G, c, wgm, rev;
    __host__ __device__ void init(int M, int N, int G_, int c_) { nM = M / BM; nN = N / BM; nwg = nM * nN; G = G_; c = c_; wgm = WGM; rev = 0; }
    __host__ __device__ bool next(int i, Unit& u) const {
        const long L = (long)i * G + c; if (L >= nwg) return false;
        int wgid = (int)L; { const int q = nwg / NXCD, r = nwg % NXCD, xcd = wgid % NXCD, off = wgid / NXCD; wgid = (xcd < r ? xcd * (q + 1) : r * (q + 1) + (xcd - r) * q) + off; }
        const int nig = wgm * nN, gid = wgid / nig, fm = gid * wgm, gsz = (nM - fm) < wgm ? (nM - fm) : wgm;
        u.pm = fm + ((wgid % nig) % gsz); u.pn = (wgid % nig) / gsz; if (rev) u.pn = nN - 1 - u.pn; return true;
    }
    __device__ __forceinline__ void a_ready(const Unit&) const {}
    __device__ __forceinline__ void done(const Unit&) const {}
};
__device__ __forceinline__ unsigned cvt_pk_bf16(float lo, float hi) { unsigned r; asm volatile("v_cvt_pk_bf16_f32 %0, %1, %2" : "=v"(r) : "v"(lo), "v"(hi)); return r; }
template <class Epi, class Sched, bool STAMP = false>
__device__ __forceinline__ void gemm_phase(PG8_LAS unsigned char* lds, const Gemm g, const Sched& S, const Epi& E, unsigned long long* stamps) {
    int tid_ = threadIdx.x; asm volatile("" : "+v"(tid_)); const int tid = tid_, wid = __builtin_amdgcn_readfirstlane(tid >> 6), lane = tid & 63, wr = wid >> 2, wc = wid & 3, fr = lane & 15, fq = lane >> 4;
    const int K = g.K, nt = K / BK;
    int ts_lo = 0, ts_hi = 0, nts = 0; const unsigned long long rt_entry = STAMP ? (unsigned long long)wall_clock64() : 0ull;
#define PG8_STAMP() do { if (STAMP && wid == 0 && nts < 64) { const unsigned long long _c = (unsigned long long)clock64(); \
        ts_lo = (lane == nts) ? (int)(unsigned)_c : ts_lo; ts_hi = (lane == nts) ? (int)(unsigned)(_c >> 32) : ts_hi; ++nts; } } while (0)
    PG8_STAMP();
    unsigned voffA[2], voffB[2];
#pragma unroll
    for (int i = 0; i < 2; ++i) { int R, C; stage_rc(tid * 16 + i * 8192, R, C); const int Rb = E.perm() ? ((R & ~31) + perm32(R & 31)) : R;
        voffA[i] = (unsigned)(R * g.lda + C) * 2u; voffB[i] = (unsigned)(Rb * K + C) * 2u; }
    const size_t kstep = (size_t)(BK * 2);
    const size_t hstep = (size_t)HALF * K * 2;
    const size_t tstep = 2 * hstep; const size_t hstepA = (size_t)HALF * g.lda * 2, tstepA = 2 * hstepA;
    const unsigned ldsw = (unsigned)wid * 1024u;
    const int aoff = lds_byte(wr * 64 + fr, fq * 8), boff = lds_byte(wc * 32 + fr, fq * 8);
#define PG8_SA(b, h) (((b) * 2 + (h)) * HTB)
#define PG8_SB(b, h) ((4 + (b) * 2 + (h)) * HTB)
#define PG8_STAGE(bufoff, gbase, voff) do { _Pragma("unroll") for (int _i = 0; _i < 2; ++_i) \
        __builtin_amdgcn_global_load_lds((const unsigned*)((const char*)(gbase) + (voff)[_i]), (PG8_LAS unsigned*)(lds + (bufoff) + ldsw + _i * 8192), 16, 0, 0); } while (0)
#define PG8_LDA(dst, b, h) do { _Pragma("unroll") for (int m = 0; m < 4; ++m) _Pragma("unroll") for (int k = 0; k < 2; ++k) dst[m][k] = *(const PG8_LAS bf16x8*)(lds + PG8_SA(b, h) + aoff + m * 2048 + k * 1024); } while (0)
#define PG8_LDB(dst, b, h) do { _Pragma("unroll") for (int n = 0; n < 2; ++n) _Pragma("unroll") for (int k = 0; k < 2; ++k) dst[n][k] = *(const PG8_LAS bf16x8*)(lds + PG8_SB(b, h) + boff + n * 2048 + k * 1024); } while (0)
#define PG8_MMA(ai, bj, At, Bt) do { __builtin_amdgcn_s_setprio(1); _Pragma("unroll") for (int m = 0; m < 4; ++m) _Pragma("unroll") for (int n = 0; n < 2; ++n) _Pragma("unroll") for (int k = 0; k < 2; ++k) \
        acc[ai][bj][m][n] = __builtin_amdgcn_mfma_f32_16x16x32_bf16(Bt[n][k], At[m][k], acc[ai][bj][m][n], 0, 0, 0); __builtin_amdgcn_s_setprio(0); } while (0)
#define PG8_WAIT_V(n) asm volatile("s_waitcnt vmcnt(" #n ")" ::: "memory")
#define PG8_WAIT_L(n) asm volatile("s_waitcnt lgkmcnt(" #n ")" ::: "memory")
#define PG8_BAR __builtin_amdgcn_s_barrier()
#define PG8_SCHED __builtin_amdgcn_sched_barrier(0)
    Unit cur, nxt; int ui = 0;
    if (!S.next(0, cur)) return;
    f32x4 acc[2][2][4][2];
#pragma unroll
    for (int a = 0; a < 2; ++a)
#pragma unroll
        for (int b = 0; b < 2; ++b)
#pragma unroll
            for (int m = 0; m < 4; ++m)
#pragma unroll
                for (int n = 0; n < 2; ++n) acc[a][b][m][n] = (f32x4){0.f, 0.f, 0.f, 0.f};
    bf16x8 At[4][2], B0[2][2], B1[2][2];
    const char* cA = (const char*)g.A + (size_t)cur.pm * tstepA; const char* cB = (const char*)g.Bt + (size_t)cur.pn * tstep;
    S.a_ready(cur);
    PG8_STAGE(PG8_SB(0, 0), cB, voffB); PG8_STAGE(PG8_SA(0, 0), cA, voffA); PG8_STAGE(PG8_SB(0, 1), cB + hstep, voffB); PG8_STAGE(PG8_SA(0, 1), cA + hstepA, voffA);
    if (wr == 1) PG8_BAR;
    PG8_WAIT_V(4); PG8_BAR;
    PG8_STAGE(PG8_SB(1, 0), cB + kstep, voffB); PG8_STAGE(PG8_SA(1, 0), cA + kstep, voffA); PG8_STAGE(PG8_SB(1, 1), cB + hstep + kstep, voffB);
    PG8_WAIT_V(6); PG8_BAR;
    PG8_STAMP();
    for (;;) {
        const bool has_next = S.next(ui + 1, nxt);
        const char* nA = has_next ? (const char*)g.A + (size_t)nxt.pm * tstepA : cA; const char* nB = has_next ? (const char*)g.Bt + (size_t)nxt.pn * tstep : cB;
        for (int t = 0; t < nt; t += 2) {
            const bool last = (t == nt - 2);
            const char* a1 = cA + (size_t)(t + 1) * kstep;
            const char* a2 = last ? nA : cA + (size_t)(t + 2) * kstep; const char* b2 = last ? nB : cB + (size_t)(t + 2) * kstep;
            const char* a3 = a2 + kstep; const char* b3 = b2 + kstep;
            if (last && has_next) S.a_ready(nxt);
            if (last) E.pre(cur, wr, fr, tid);
            PG8_LDB(B0, 0, 0); PG8_SCHED; PG8_LDA(At, 0, 0); PG8_STAGE(PG8_SA(1, 1), a1 + hstepA, voffA);
            PG8_WAIT_L(8); PG8_BAR; PG8_WAIT_L(0); PG8_MMA(0, 0, At, B0); PG8_BAR; PG8_SCHED;
            PG8_LDB(B1, 0, 1); PG8_STAGE(PG8_SB(0, 0), b2, voffB);
            PG8_BAR; PG8_WAIT_L(0); PG8_MMA(0, 1, At, B1); PG8_BAR;
            PG8_LDA(At, 0, 1); PG8_STAGE(PG8_SA(0, 0), a2, voffA);
            PG8_BAR; PG8_WAIT_L(0); PG8_MMA(1, 0, At, B0); PG8_BAR; PG8_SCHED;
            PG8_STAGE(PG8_SB(0, 1), b2 + hstep, voffB);
            PG8_WAIT_V(6); PG8_BAR; PG8_MMA(1, 1, At, B1); PG8_BAR;
            PG8_LDB(B0, 1, 0); PG8_SCHED; PG8_LDA(At, 1, 0); PG8_STAGE(PG8_SA(0, 1), a2 + hstepA, voffA);
            PG8_WAIT_L(8); PG8_BAR; PG8_WAIT_L(0); PG8_MMA(0, 0, At, B0); PG8_BAR; PG8_SCHED;
            PG8_LDB(B1, 1, 1); PG8_STAGE(PG8_SB(1, 0), b3, voffB);
            PG8_BAR; PG8_WAIT_L(0); PG8_MMA(0, 1, At, B1); PG8_BAR;
            PG8_LDA(At, 1, 1); PG8_STAGE(PG8_SA(1, 0), a3, voffA);
            PG8_BAR; PG8_WAIT_L(0); PG8_MMA(1, 0, At, B0); PG8_BAR; PG8_SCHED;
            PG8_STAGE(PG8_SB(1, 1), b3 + hstep, voffB);
            PG8_WAIT_V(6); PG8_BAR; PG8_MMA(1, 1, At, B1); PG8_BAR;
        }
        PG8_STAMP();
        if constexpr (!Epi::AFTER_DRAIN) { E(acc, cur, wr, wc, fr, fq); S.done(cur); }
        PG8_STAMP();
        if (!has_next) break;
#pragma unroll
        for (int a = 0; a < 2; ++a)
#pragma unroll
            for (int b = 0; b < 2; ++b)
#pragma unroll
                for (int m = 0; m < 4; ++m)
#pragma unroll
                    for (int n = 0; n < 2; ++n) acc[a][b][m][n] = (f32x4){0.f, 0.f, 0.f, 0.f};
        cur = nxt; cA = nA; cB = nB; ++ui;
    }
    PG8_WAIT_V(0);
    if (wr == 0) PG8_BAR;
    PG8_BAR;
    if constexpr (Epi::AFTER_DRAIN) { E.fused(acc, cur, wr, wc, fr, fq, lds, wid, lane); S.done(cur); }
    PG8_STAMP();
    if (STAMP && wid == 0) { stamps[lane] = lane < nts ? (((unsigned long long)(unsigned)ts_hi << 32) | (unsigned)ts_lo) : 0ull;
        if (lane == 62) stamps[62] = rt_entry; if (lane == 63) stamps[63] = (unsigned long long)wall_clock64(); }
#undef PG8_STAMP
#undef PG8_SA
#undef PG8_SB
#undef PG8_STAGE
#undef PG8_LDA
#undef PG8_LDB
#undef PG8_MMA
#undef PG8_WAIT_V
#undef PG8_WAIT_L
#undef PG8_BAR
#undef PG8_SCHED
}
}

#define LAS __attribute__((address_space(3)))
typedef unsigned short bf16_t;
typedef short bf16x8 __attribute__((ext_vector_type(8)));
typedef float f32x4 __attribute__((ext_vector_type(4)));
typedef float f32x2 __attribute__((ext_vector_type(2)));
typedef float f32x16 __attribute__((ext_vector_type(16)));
typedef unsigned u32x4 __attribute__((ext_vector_type(4)));
typedef unsigned u32x2 __attribute__((ext_vector_type(2)));
typedef __bf16 bf16x2_t __attribute__((ext_vector_type(2)));

constexpr int DM = 2048, DFF = 5632, SEQ = 4096, NSEQ = 12, MTOT = NSEQ * SEQ, NPROMPT = 4 * SEQ;
constexpr int MC = 16384, NCH = MTOT / MC, SPC = MC / SEQ;
constexpr int ZW0 = 4352, ZW1 = 3072;
constexpr int NTHR = 512, LDS_STAGE = 132096, LDS_BYTES = LDS_STAGE + 256;
constexpr float LOG2E = 1.4426950408889634f, EPSN = 1e-6f;

constexpr size_t SZ_WGU = (size_t)2 * DFF * DM * 2, SZ_WD = (size_t)DM * DFF * 2;
constexpr size_t OFF_WGU = 0;
constexpr size_t OFF_WD = OFF_WGU + 4 * SZ_WGU;
constexpr size_t OFF_WIN0 = OFF_WD + 4 * SZ_WD;
constexpr size_t OFF_WQB = OFF_WIN0 + (size_t)ZW0 * DM * 2;
constexpr size_t OFF_WKVB = OFF_WQB + (size_t)1536 * 512 * 2;
constexpr size_t OFF_WOUT0 = OFF_WKVB + (size_t)2048 * 512 * 2;
constexpr size_t OFF_WIN1 = OFF_WOUT0 + (size_t)DM * DM * 2;
constexpr size_t OFF_WOUT1 = OFF_WIN1 + (size_t)ZW1 * DM * 2;
constexpr size_t OFF_ROPE32 = OFF_WOUT1 + (size_t)DM * DM * 2;
constexpr size_t OFF_ROPE64 = OFF_ROPE32 + 2 * (size_t)SEQ * 32 * 4;
constexpr size_t OFF_SSQ = OFF_ROPE64 + 2 * (size_t)SEQ * 64 * 4;
constexpr size_t OFF_SSQ2 = OFF_SSQ + 6 * (size_t)MTOT * 4;
constexpr size_t OFF_XB = OFF_SSQ2 + 2 * (size_t)MTOT * 4;
constexpr size_t OFF_U = OFF_XB + (size_t)MTOT * DM * 2;
constexpr size_t OFF_H = OFF_U;
constexpr size_t OFF_Z = OFF_U;
constexpr size_t OFF_QA = OFF_Z + (size_t)MC * ZW0 * 2;
constexpr size_t OFF_KVA = OFF_QA + (size_t)MC * 512 * 2;
constexpr size_t OFF_QR = OFF_KVA + (size_t)MC * 512 * 2;
constexpr size_t OFF_KVR = OFF_QR + (size_t)MC * 1536 * 2;
constexpr size_t OFF_KF = OFF_KVR + (size_t)MC * 2048 * 2;
constexpr size_t OFF_VT = OFF_KF + (size_t)MC * 1536 * 2;
constexpr size_t OFF_ATT = OFF_VT + (size_t)MC * 1024 * 2;
constexpr size_t OFF_UEND = OFF_ATT + (size_t)MC * 2048 * 2;
constexpr size_t OFF_BAR = OFF_UEND;
static_assert((size_t)MC * DFF * 2 <= OFF_UEND - OFF_U, "H must fit in the union");
constexpr size_t BAR_BYTES = 16384;
constexpr size_t WS_END = OFF_BAR + BAR_BYTES;

struct Params { const float* in[21]; float* out; unsigned char* ws; int ph_lo, ph_hi; };
enum { I_XP = 0, I_XS, I_FNORM, I_WG, I_WU, I_WDN, I_MNORM, I_ABIN, I_QANORM, I_WQB, I_KVANORM, I_WKVB, I_QNORM, I_KNORM, I_CONVW, I_ABOUT, I_CIN, I_CQN, I_CKN, I_CSINK, I_COUT };

__device__ __forceinline__ unsigned pk2(float a, float b) { f32x2 v = {a, b}; bf16x2_t r = __builtin_convertvector(v, bf16x2_t); return __builtin_bit_cast(unsigned, r); }
__device__ __forceinline__ float bflo(unsigned u) { return __uint_as_float(u << 16); }
__device__ __forceinline__ float bfhi(unsigned u) { return __uint_as_float(u & 0xffff0000u); }
__device__ __forceinline__ float bf1(bf16_t u) { return __uint_as_float(((unsigned)u) << 16); }
__device__ __forceinline__ bf16_t tobf(float a) { return (bf16_t)(pk2(a, 0.f) & 0xffffu); }
__device__ __forceinline__ int tid_opaque() { int t = threadIdx.x; asm volatile("" : "+v"(t)); return t; }
__device__ __forceinline__ float shflx(float v, int lane, int o) { return __int_as_float(__builtin_amdgcn_ds_bpermute((lane ^ o) << 2, __float_as_int(v))); }
__device__ __forceinline__ float wave_sum_l(float v, int lane) {
#pragma unroll
    for (int o = 32; o >= 1; o >>= 1) v += shflx(v, lane, o);
    return v;
}
#define OPAQUE(ptr) asm volatile("" : "+s"(ptr))

constexpr float FXS = 4096.0f;
__device__ __forceinline__ void fx_add(float* slot, float part) { (void)__hip_atomic_fetch_add((unsigned*)slot, (unsigned)(part * FXS + 0.5f), __ATOMIC_RELAXED, __HIP_MEMORY_SCOPE_AGENT); }
__device__ __forceinline__ float row_rs(const float* ssq, int grow) { return ssq ? rsqrtf(ssq[grow] * (1.0f / DM) + EPSN) : 1.0f; }
struct EpiStoreBf16 {
    static constexpr bool AFTER_DRAIN = false;
    bf16_t* O; const float* ssq; float* sq2; int ldc; float inv_n;
    __device__ __forceinline__ void operator()(const f32x4 (&acc)[2][2][4][2], const pg8::Unit& u, int wr, int wc, int fr, int fq, const float (&pre)[8]) const {
        const int row0 = u.pm * 256 + wr * 64 + fr, col0 = u.pn * 256 + wc * 32 + 8 * fq, lane = fq * 16 + fr;
        const bool acc2 = sq2 != nullptr && u.pn < 4;
#pragma unroll
        for (int ai = 0; ai < 2; ++ai)
#pragma unroll
            for (int m = 0; m < 4; ++m) { const int row = row0 + ai * 128 + m * 16; bf16_t* rowp = O + (size_t)row * ldc + col0;
                const float rs = ssq ? rsqrtf((float)__float_as_uint(pre[ai * 4 + m]) * (inv_n * (1.0f / FXS)) + EPSN) : 1.0f;
                float part = 0.f;
#pragma unroll
                for (int bj = 0; bj < 2; ++bj) { const f32x4 v0 = acc[ai][bj][m][0] * rs, v1 = acc[ai][bj][m][1] * rs;
                    u32x4 o = {pk2(v0[0], v0[1]), pk2(v0[2], v0[3]), pk2(v1[0], v1[1]), pk2(v1[2], v1[3])};
                    *(u32x4*)(rowp + bj * 128) = o;
                    if (acc2) part += v0[0] * v0[0] + v0[1] * v0[1] + v0[2] * v0[2] + v0[3] * v0[3] + v1[0] * v1[0] + v1[1] * v1[1] + v1[2] * v1[2] + v1[3] * v1[3]; }
                if (acc2) { part += shflx(part, lane, 16); part += shflx(part, lane, 32);
                    if (fq == 0) fx_add(sq2 + (size_t)(u.pn >> 1) * MTOT + row, part); } }
    }
};
__device__ __forceinline__ unsigned silu_mul_pk(f32x2 g, f32x2 u, f32x2 c1  , f32x2 c2  ) {
    const f32x2 a = g * c1;
    f32x2 e; e[0] = __builtin_amdgcn_exp2f(a[0]); e[1] = __builtin_amdgcn_exp2f(a[1]);
    const f32x2 d = e + 1.0f;
    f32x2 r; r[0] = __builtin_amdgcn_rcpf(d[0]); r[1] = __builtin_amdgcn_rcpf(d[1]);
    const f32x2 o = ((g * u) * c2) * r;
    return pk2(o[0], o[1]);
}
struct EpiSwiglu {
    static constexpr bool AFTER_DRAIN = false;
    bf16_t* H; const float* ssq; int ldc; int pad_;
    __device__ __forceinline__ void operator()(const f32x4 (&acc)[2][2][4][2], const pg8::Unit& u, int wr, int wc, int fr, int fq, const float (&pre)[8]) const {
        const int row0 = u.pm * 256 + wr * 64 + fr, col0 = u.pn * 128 + wc * 32 + 8 * fq;
#pragma unroll
        for (int ai = 0; ai < 2; ++ai)
#pragma unroll
            for (int m = 0; m < 4; ++m) { const int row = row0 + ai * 128 + m * 16; bf16_t* rowp = H + (size_t)row * ldc + col0;
                const float rs = rsqrtf((float)__float_as_uint(pre[ai * 4 + m]) * (1.0f / (DM * FXS)) + EPSN);
                const float k1 = -rs * LOG2E, k2 = rs * rs; const f32x2 c1 = {k1, k1}, c2 = {k2, k2};
                const f32x4 g0 = acc[ai][0][m][0], g1 = acc[ai][0][m][1], u0 = acc[ai][1][m][0], u1 = acc[ai][1][m][1];
                u32x4 o = {silu_mul_pk((f32x2){g0[0], g0[1]}, (f32x2){u0[0], u0[1]}, c1, c2), silu_mul_pk((f32x2){g0[2], g0[3]}, (f32x2){u0[2], u0[3]}, c1, c2),
                           silu_mul_pk((f32x2){g1[0], g1[1]}, (f32x2){u1[0], u1[1]}, c1, c2), silu_mul_pk((f32x2){g1[2], g1[3]}, (f32x2){u1[2], u1[3]}, c1, c2)};
                *(u32x4*)rowp = o; }
    }
};
typedef const float __attribute__((address_space(1)))* gcf_t;
typedef float __attribute__((address_space(1)))* gf_t;
typedef bf16_t __attribute__((address_space(1)))* gb_t;
struct EpiResid {
    static constexpr bool AFTER_DRAIN = false;
    float* dst; const float* src0; const float* src1; bf16_t* xb; float* ssq_out; int split_row; int row_base; float scale; int fi;
    __device__ __forceinline__ void operator()(const f32x4 (&acc)[2][2][4][2], const pg8::Unit& u, int wr, int wc, int fr, int fq) const {
        const int grow0 = row_base + u.pm * 256 + wr * 64 + fr, col0 = u.pn * 256 + wc * 32 + 8 * fq, lane = fq * 16 + fr;
        const gf_t dbase = (gf_t)dst + (size_t)grow0 * DM + col0;
        const gb_t xbase = (gb_t)xb + (size_t)grow0 * DM + col0;
        const bool wx = ssq_out != nullptr, wf = dst != nullptr;
        if (fi) {
            const bool lo = (row_base + u.pm * 256) < split_row;
            const gcf_t sbase = (gcf_t)(lo ? src0 : src1 - (size_t)split_row * DM) + (size_t)grow0 * DM + col0;
            f32x4 xv[2][8];
#define RESID_LOAD(buf, jp) do { _Pragma("unroll") for (int jj = 0; jj < 2; ++jj) { const int j_ = (jp) * 2 + jj, ai_ = j_ >> 2, m_ = j_ & 3; \
            _Pragma("unroll") for (int c_ = 0; c_ < 4; ++c_) xv[buf][jj * 4 + c_] = *(const f32x4 __attribute__((address_space(1)))*)(sbase + (size_t)(ai_ * 128 + m_ * 16) * DM + (c_ >> 1) * 128 + (c_ & 1) * 4); } } while (0)
            RESID_LOAD(0, 0);
#pragma unroll
            for (int jp = 0; jp < 4; ++jp) {
                if (jp + 1 < 4) { if ((jp & 1) == 0) RESID_LOAD(1, jp + 1); else RESID_LOAD(0, jp + 1); }
#pragma unroll
                for (int jj = 0; jj < 2; ++jj) { const int j = jp * 2 + jj, ai = j >> 2, m = j & 3; const size_t ro = (size_t)(ai * 128 + m * 16) * DM;
                    float part = 0.f;
#pragma unroll
                    for (int bj = 0; bj < 2; ++bj) {
                        const f32x4 v0 = xv[jp & 1][jj * 4 + bj * 2] + scale * acc[ai][bj][m][0], v1 = xv[jp & 1][jj * 4 + bj * 2 + 1] + scale * acc[ai][bj][m][1];
                        u32x4 o = {pk2(v0[0], v0[1]), pk2(v0[2], v0[3]), pk2(v1[0], v1[1]), pk2(v1[2], v1[3])};
                        *(u32x4 __attribute__((address_space(1)))*)(xbase + ro + bj * 128) = o;
                        part += v0[0] * v0[0] + v0[1] * v0[1] + v0[2] * v0[2] + v0[3] * v0[3] + v1[0] * v1[0] + v1[1] * v1[1] + v1[2] * v1[2] + v1[3] * v1[3]; }
                    part += shflx(part, lane, 16); part += shflx(part, lane, 32);
                    if (fq == 0) fx_add(ssq_out + grow0 + ai * 128 + m * 16, part); }
            }
#undef RESID_LOAD
        } else {
            u32x4 raw[16];
#pragma unroll
            for (int j = 0; j < 8; ++j)
#pragma unroll
                for (int bj = 0; bj < 2; ++bj) raw[j * 2 + bj] = *(const u32x4 __attribute__((address_space(1)))*)(xbase + (size_t)((j >> 2) * 128 + (j & 3) * 16) * DM + bj * 128);
#pragma unroll
            for (int j = 0; j < 8; ++j) { const int ai = j >> 2, m = j & 3; const size_t ro = (size_t)(ai * 128 + m * 16) * DM;
                float part = 0.f;
#pragma unroll
                for (int bj = 0; bj < 2; ++bj) { const u32x4 rw = raw[j * 2 + bj];
                    const f32x4 x0 = {bflo(rw[0]), bfhi(rw[0]), bflo(rw[1]), bfhi(rw[1])}, x1 = {bflo(rw[2]), bfhi(rw[2]), bflo(rw[3]), bfhi(rw[3])};
                    const f32x4 v0 = x0 + scale * acc[ai][bj][m][0], v1 = x1 + scale * acc[ai][bj][m][1];
                    if (wf) { *(f32x4 __attribute__((address_space(1)))*)(dbase + ro + bj * 128) = v0; *(f32x4 __attribute__((address_space(1)))*)(dbase + ro + bj * 128 + 4) = v1; }
                    if (wx) { u32x4 o = {pk2(v0[0], v0[1]), pk2(v0[2], v0[3]), pk2(v1[0], v1[1]), pk2(v1[2], v1[3])};
                        *(u32x4 __attribute__((address_space(1)))*)(xbase + ro + bj * 128) = o;
                        part += v0[0] * v0[0] + v0[1] * v0[1] + v0[2] * v0[2] + v0[3] * v0[3] + v1[0] * v1[0] + v1[1] * v1[1] + v1[2] * v1[2] + v1[3] * v1[3]; } }
                if (wx) { part += shflx(part, lane, 16); part += shflx(part, lane, 32);
                    if (fq == 0) fx_add(ssq_out + grow0 + ai * 128 + m * 16, part); } }
        }
    }
};

__device__ __forceinline__ int map_row(int mk, int n) {
    if (mk == 1) return (n >> 7) * 256 + (n & 127);
    if (mk == 2) return (n >> 7) * 256 + 128 + (n & 127);
    if (mk == 3) return n < 1024 ? n : (n < 1088 ? n + 3072 : n - 64);
    return n;
}
__device__ __forceinline__ void conv_set(const Params& p, LAS unsigned char* lds, unsigned char* ws, int m_lo, int m_hi) {
    const int tid = tid_opaque();
    LAS float* sm = (LAS float*)lds;
    for (int mi = m_lo; mi < m_hi; ++mi) {
        int isrc, ign = -1, K, N, mk = 0; size_t soff = 0, goff = 0, doff;
        if (mi < 12) { const int f = mi / 3, w = mi % 3, slot = f;
            if (w == 0) { isrc = I_WG; soff = (size_t)f * DM * DFF; K = DM; N = DFF; doff = OFF_WGU + slot * SZ_WGU; mk = 1; ign = I_FNORM; goff = f * DM; }
            else if (w == 1) { isrc = I_WU; soff = (size_t)f * DM * DFF; K = DM; N = DFF; doff = OFF_WGU + slot * SZ_WGU; mk = 2; ign = I_FNORM; goff = f * DM; }
            else { isrc = I_WDN; soff = (size_t)f * DFF * DM; K = DFF; N = DM; doff = OFF_WD + slot * SZ_WD; } }
        else if (mi == 12) { isrc = I_ABIN; K = DM; N = 4160; doff = OFF_WIN0; mk = 3; ign = I_MNORM; }
        else if (mi == 13) { isrc = I_WQB; K = 512; N = 1536; doff = OFF_WQB; ign = I_QANORM; }
        else if (mi == 14) { isrc = I_WKVB; K = 512; N = 2048; doff = OFF_WKVB; ign = I_KVANORM; }
        else if (mi == 15) { isrc = I_ABOUT; K = DM; N = DM; doff = OFF_WOUT0; }
        else if (mi == 16) { isrc = I_CIN; K = DM; N = 3072; doff = OFF_WIN1; ign = I_MNORM; goff = DM; }
        else { isrc = I_COUT; K = DM; N = DM; doff = OFF_WOUT1; }
        const float* src = p.in[isrc] + soff; const float* gain = ign >= 0 ? p.in[ign] + goff : nullptr; bf16_t* dst = (bf16_t*)(ws + doff);
        const int tn = N >> 6, tk = K >> 8, nt = tn * tk;
        f32x4 v[8], vn[8];
        int t = blockIdx.x;
        if (t < nt) { const int k0 = (t / tn) << 8, n0 = (t % tn) << 6;
#pragma unroll
            for (int i = 0; i < 8; ++i) { const int r = (tid >> 4) + 32 * i, c4 = tid & 15; v[i] = *(const f32x4*)(src + (size_t)(k0 + r) * N + n0 + 4 * c4); } }
        for (; t < nt; t += gridDim.x) {
            const int k0 = (t / tn) << 8, n0 = (t % tn) << 6;
            f32x4 gv[8];
            if (gain) {
#pragma unroll
                for (int i = 0; i < 4; ++i) { const int kc = ((tid >> 3) & 7) | (i << 3); gv[2 * i] = *(const f32x4*)(gain + k0 + kc * 8); gv[2 * i + 1] = *(const f32x4*)(gain + k0 + kc * 8 + 4); } }
            const int t2 = t + gridDim.x;
            if (t2 < nt) { const int k2 = (t2 / tn) << 8, n2 = (t2 % tn) << 6;
#pragma unroll
                for (int i = 0; i < 8; ++i) { const int r = (tid >> 4) + 32 * i, c4 = tid & 15; vn[i] = *(const f32x4*)(src + (size_t)(k2 + r) * N + n2 + 4 * c4); } }
#pragma unroll
            for (int i = 0; i < 8; ++i) { const int r = (tid >> 4) + 32 * i, c4 = tid & 15;
#pragma unroll
                for (int j = 0; j < 4; ++j) sm[r * 65 + 4 * c4 + j] = v[i][j]; }
            __syncthreads();
#pragma unroll
            for (int i = 0; i < 4; ++i) { const int q = tid + 512 * i, n = (q & 7) | (((q >> 6) & 7) << 3), kc = ((q >> 3) & 7) | ((q >> 9) << 3);
                float e[8];
#pragma unroll
                for (int j = 0; j < 8; ++j) e[j] = sm[(kc * 8 + j) * 65 + n];
                if (gain) {
#pragma unroll
                    for (int j = 0; j < 4; ++j) { e[j] *= gv[2 * i][j]; e[4 + j] *= gv[2 * i + 1][j]; } }
                u32x4 o = {pk2(e[0], e[1]), pk2(e[2], e[3]), pk2(e[4], e[5]), pk2(e[6], e[7])};
                *(u32x4*)(dst + (size_t)map_row(mk, n0 + n) * K + k0 + kc * 8) = o; }
            __syncthreads();
#pragma unroll
            for (int i = 0; i < 8; ++i) v[i] = vn[i];
        }
    }
}
__device__ __forceinline__ void init_phase(const Params& p, LAS unsigned char* lds, unsigned char* ws) {
    conv_set(p, lds, ws, 0, 18);
    const int tid = tid_opaque();
    const int gt = blockIdx.x * NTHR + tid, gn = gridDim.x * NTHR;
    { u32x4* z = (u32x4*)(ws + OFF_WIN0 + (size_t)4160 * DM * 2); const int n16 = 192 * DM * 2 / 16; const u32x4 zero = {0u, 0u, 0u, 0u};
      for (int i = gt; i < n16; i += gn) z[i] = zero;
      u32x4* q = (u32x4*)(ws + OFF_SSQ + (size_t)MTOT * 4); const int m16 = 7 * MTOT * 4 / 16;
      for (int i = gt; i < m16; i += gn) q[i] = zero; }
    { float* c32 = (float*)(ws + OFF_ROPE32); float* s32 = c32 + SEQ * 32; float* c64 = (float*)(ws + OFF_ROPE64); float* s64 = c64 + SEQ * 64;
      for (int i = gt; i < SEQ * 32; i += gn) { const int pos = i >> 5, j = i & 31; const float inv = 1.0f / powf(10000.0f, (float)(2 * j) / 64.0f); const float ang = (float)pos * inv;
          const double a = (double)ang; const double kk = rint(a * 0.15915494309189535); const float rr = (float)(a - kk * 6.283185307179586);
          c32[i] = cosf(rr); s32[i] = sinf(rr); }
      for (int i = gt; i < SEQ * 64; i += gn) { const int pos = i >> 6, j = i & 63; const float inv = 1.0f / powf(10000.0f, (float)(2 * j) / 128.0f); const float ang = (float)pos * inv;
          const double a = (double)ang; const double kk = rint(a * 0.15915494309189535); const float rr = (float)(a - kk * 6.283185307179586);
          c64[i] = cosf(rr); s64[i] = sinf(rr); } }
    { const int lane = tid & 63, wave = tid >> 6;
      bf16_t* XB = (bf16_t*)(ws + OFF_XB); float* SSQ0 = (float*)(ws + OFF_SSQ);
      for (int r = blockIdx.x * 8 + wave; r < MTOT; r += gridDim.x * 8) {
        const float* xr = r < NPROMPT ? p.in[I_XP] + (size_t)r * DM : p.in[I_XS] + (size_t)(r - NPROMPT) * DM;
        f32x4 v[8]; float ss = 0.f;
#pragma unroll
        for (int i = 0; i < 8; ++i) { v[i] = *(const f32x4*)(xr + lane * 4 + 256 * i); ss += v[i][0] * v[i][0] + v[i][1] * v[i][1] + v[i][2] * v[i][2] + v[i][3] * v[i][3]; }
        ss = wave_sum_l(ss, lane);
#pragma unroll
        for (int i = 0; i < 8; ++i) { u32x2 o = {pk2(v[i][0], v[i][1]), pk2(v[i][2], v[i][3])}; *(u32x2*)(XB + (size_t)r * DM + lane * 4 + 256 * i) = o; }
        if (lane == 0) ((unsigned*)SSQ0)[r] = (unsigned)(ss * FXS + 0.5f);
      } }
}

__device__ __forceinline__ void unpack8(const u32x4 u, float (&f)[8]) {
#pragma unroll
    for (int i = 0; i < 4; ++i) { f[2 * i] = bflo(u[i]); f[2 * i + 1] = bfhi(u[i]); }
}
__device__ __forceinline__ void mla_conv(const Params& p, unsigned char* ws) {
    const int tid = tid_opaque(), lane = tid & 63, wave = tid >> 6;
    const bf16_t* Z = (const bf16_t*)(ws + OFF_Z); bf16_t* ATT = (bf16_t*)(ws + OFF_ATT);
    const float* cw = p.in[I_CONVW] + lane * 16;
    for (int r = blockIdx.x * 8 + wave; r < MC; r += gridDim.x * 8) {
        const bf16_t* z = Z + (size_t)r * ZW0;
        const int t = r & (SEQ - 1);
#pragma unroll
        for (int hv = 0; hv < 2; ++hv) {
            const int c0 = lane * 16 + hv * 8;
            float gb[8], gc[8], uu[8], cu[8], acc[8];
            unpack8(*(const u32x4*)(z + 1024 + c0), gb);
            unpack8(*(const u32x4*)(z + 2048 + c0), gc); unpack8(*(const u32x4*)(z + 3072 + c0), uu);
            const f32x4 w1a = *(const f32x4*)(cw + 1024 + hv * 8), w1b = *(const f32x4*)(cw + 1024 + hv * 8 + 4);
#pragma unroll
            for (int j = 0; j < 8; ++j) { cu[j] = gc[j] * uu[j]; acc[j] = cu[j] * (j < 4 ? w1a[j] : w1b[j - 4]); }
            if (t > 0) { unpack8(*(const u32x4*)(z - ZW0 + 2048 + c0), gc); unpack8(*(const u32x4*)(z - ZW0 + 3072 + c0), uu);
                const f32x4 w0a = *(const f32x4*)(cw + hv * 8), w0b = *(const f32x4*)(cw + hv * 8 + 4);
#pragma unroll
                for (int j = 0; j < 8; ++j) acc[j] += gc[j] * uu[j] * (j < 4 ? w0a[j] : w0b[j - 4]); }
            if (t < SEQ - 1) { unpack8(*(const u32x4*)(z + ZW0 + 2048 + c0), gc); unpack8(*(const u32x4*)(z + ZW0 + 3072 + c0), uu);
                const f32x4 w2a = *(const f32x4*)(cw + 2048 + hv * 8), w2b = *(const f32x4*)(cw + 2048 + hv * 8 + 4);
#pragma unroll
                for (int j = 0; j < 8; ++j) acc[j] += gc[j] * uu[j] * (j < 4 ? w2a[j] : w2b[j - 4]); }
            u32x4 o = {pk2(gb[0] * acc[0], gb[1] * acc[1]), pk2(gb[2] * acc[2], gb[3] * acc[3]), pk2(gb[4] * acc[4], gb[5] * acc[5]), pk2(gb[6] * acc[6], gb[7] * acc[7])};
            *(u32x4*)(ATT + (size_t)r * DM + 1024 + c0) = o;
        }
    }
}
__device__ __forceinline__ void vt_transpose(LAS unsigned char* lds, const bf16_t* V, int ld, int coff, int hstride, int HK, bf16_t* VT) {
    const int tid = tid_opaque();
    LAS bf16_t* sm = (LAS bf16_t*)lds;
    const int ngrp = (MC / 256) * HK;
    for (int grp = blockIdx.x; grp < ngrp; grp += gridDim.x) {
        const int h = grp % HK, tb4 = grp / HK;
        const int row0 = tb4 * 256, seq = row0 / SEQ, t0 = row0 % SEQ;
        u32x4 v[8];
#pragma unroll
        for (int i = 0; i < 8; ++i) { const int q = tid + 512 * i, t = q & 255, dc = q >> 8;
            v[i] = *(const u32x4*)(V + (size_t)(row0 + t) * ld + coff + h * hstride + dc * 8); }
#pragma unroll
        for (int i = 0; i < 8; ++i) { const int q = tid + 512 * i, t = q & 255, dc = q >> 8; LAS bf16_t* d = sm + (t >> 6) * (128 * 72) + (t & 63);
#pragma unroll
            for (int j = 0; j < 4; ++j) { d[(dc * 8 + 2 * j) * 72] = (bf16_t)(v[i][j] & 0xffffu); d[(dc * 8 + 2 * j + 1) * 72] = (bf16_t)(v[i][j] >> 16); } }
        __syncthreads();
#pragma unroll
        for (int i = 0; i < 8; ++i) { const int q = tid + 512 * i, tc = q & 31, d = q >> 5;
            const u32x4 w = *(const LAS u32x4*)(sm + (tc >> 3) * (128 * 72) + d * 72 + (tc & 7) * 8);
            *(u32x4*)(VT + ((size_t)(seq * HK + h) * 128 + d) * SEQ + t0 + tc * 8) = w; }
        __syncthreads();
    }
}
__device__ __forceinline__ void ld8(const float* g, float (&o)[8]) { const f32x4 a = *(const f32x4*)g, b = *(const f32x4*)(g + 4);
#pragma unroll
    for (int j = 0; j < 4; ++j) { o[j] = a[j]; o[4 + j] = b[j]; } }
__device__ __forceinline__ u32x4 pack8(const float (&f)[8]) { u32x4 o = {pk2(f[0], f[1]), pk2(f[2], f[3]), pk2(f[4], f[5]), pk2(f[6], f[7])}; return o; }
__device__ __forceinline__ void mla_prep2(const Params& p, unsigned char* ws, LAS unsigned char* lds) {
    const int tid = tid_opaque(), lane = tid & 63, wave = tid >> 6;
    const bf16_t* Z = (const bf16_t*)(ws + OFF_Z); bf16_t* QR = (bf16_t*)(ws + OFF_QR); const bf16_t* KVR = (const bf16_t*)(ws + OFF_KVR); bf16_t* KF = (bf16_t*)(ws + OFF_KF);
    const float* c32 = (const float*)(ws + OFF_ROPE32); const float* s32 = c32 + SEQ * 32;
    const bool act = lane < 48; const int hsel = lane >= 24, li = act ? lane - hsel * 24 : 0, base = hsel * 24, l7 = li & 7;
    float qn[8], kn[8]; ld8(p.in[I_QNORM] + li * 8, qn); ld8(p.in[I_KNORM] + li * 8, kn);
    const bool isrope = li >= 16; const float sgn = li < 20 ? -1.f : 1.f;
    for (int r = blockIdx.x * 8 + wave; r < MC; r += gridDim.x * 8) {
        const int pos = r & (SEQ - 1);
        float cs[8], sn[8];
        if (isrope) { ld8(c32 + pos * 32 + (li & 3) * 8, cs); ld8(s32 + pos * 32 + (li & 3) * 8, sn); }
        u32x4 raw[8];
#pragma unroll
        for (int it = 0; it < 4; ++it) { const int head = it * 2 + hsel;
            raw[it] = *(const u32x4*)(QR + (size_t)r * 1536 + head * 192 + li * 8);
            raw[4 + it] = isrope ? *(const u32x4*)(Z + (size_t)r * ZW0 + 4096 + (li - 16) * 8) : *(const u32x4*)(KVR + (size_t)r * 2048 + head * 256 + li * 8); }
#pragma unroll
        for (int it = 0; it < 8; ++it) { const int head = (it & 3) * 2 + hsel; const bool isk = it >= 4;
            float f[8]; unpack8(raw[it], f);
            float ss = 0.f;
#pragma unroll
            for (int j = 0; j < 8; ++j) ss += f[j] * f[j];
            ss += shflx(ss, lane, 1); ss += shflx(ss, lane, 2); ss += shflx(ss, lane, 4);
            const float tot = __int_as_float(__builtin_amdgcn_ds_bpermute((base + l7) << 2, __float_as_int(ss))) + __int_as_float(__builtin_amdgcn_ds_bpermute((base + 8 + l7) << 2, __float_as_int(ss)))
                            + __int_as_float(__builtin_amdgcn_ds_bpermute((base + 16 + l7) << 2, __float_as_int(ss)));
            const float rs = rsqrtf(tot * (1.0f / 192.0f) + EPSN);
            float n[8], o[8];
#pragma unroll
            for (int j = 0; j < 8; ++j) n[j] = f[j] * rs * (isk ? kn[j] : qn[j]);
#pragma unroll
            for (int j = 0; j < 8; ++j) { const float pr = shflx(n[j], lane, 4); o[j] = isrope ? n[j] * cs[j] + sgn * pr * sn[j] : n[j]; }
            if (act) *(u32x4*)((isk ? KF : QR) + (size_t)r * 1536 + head * 192 + li * 8) = pack8(o);
        }
    }
    vt_transpose(lds, KVR, 2048, 128, 256, 8, (bf16_t*)(ws + OFF_VT));
    mla_conv(p, ws);
}
__device__ __forceinline__ void gqa_prep(const Params& p, unsigned char* ws, LAS unsigned char* lds) {
    const int tid = tid_opaque(), lane = tid & 63, wave = tid >> 6;
    const bf16_t* Z = (const bf16_t*)(ws + OFF_Z); bf16_t* Q1 = (bf16_t*)(ws + OFF_KVR); bf16_t* K1 = (bf16_t*)(ws + OFF_QA);
    const float* c64 = (const float*)(ws + OFF_ROPE64); const float* s64 = c64 + SEQ * 64;
    const int g4 = lane >> 4, li = lane & 15;
    float qn[8], kn[8]; ld8(p.in[I_CQN] + li * 8, qn); ld8(p.in[I_CKN] + li * 8, kn);
    const float sgn = li < 8 ? -1.f : 1.f;
    for (int r = blockIdx.x * 8 + wave; r < MC; r += gridDim.x * 8) {
        const int pos = r & (SEQ - 1);
        float cs[8], sn[8]; ld8(c64 + pos * 64 + (li & 7) * 8, cs); ld8(s64 + pos * 64 + (li & 7) * 8, sn);
        u32x4 raw[5];
#pragma unroll
        for (int it = 0; it < 5; ++it) raw[it] = *(const u32x4*)(Z + (size_t)r * ZW1 + (it * 4 + g4) * 128 + li * 8);
#pragma unroll
        for (int it = 0; it < 5; ++it) { const int head = it * 4 + g4; const bool isk = it == 4;
            float f[8]; unpack8(raw[it], f);
            float ss = 0.f;
#pragma unroll
            for (int j = 0; j < 8; ++j) ss += f[j] * f[j];
            ss += shflx(ss, lane, 1); ss += shflx(ss, lane, 2); ss += shflx(ss, lane, 4); ss += shflx(ss, lane, 8);
            const float rs = rsqrtf(ss * (1.0f / 128.0f) + EPSN);
            float n[8], o[8];
#pragma unroll
            for (int j = 0; j < 8; ++j) n[j] = f[j] * rs * (isk ? kn[j] : qn[j]);
#pragma unroll
            for (int j = 0; j < 8; ++j) { const float pr = shflx(n[j], lane, 8); o[j] = n[j] * cs[j] + sgn * pr * sn[j]; }
            bf16_t* op = isk ? K1 + (size_t)r * 512 + g4 * 128 + li * 8 : Q1 + (size_t)r * 2048 + head * 128 + li * 8;
            *(u32x4*)op = pack8(o);
        }
    }
    vt_transpose(lds, Z, ZW1, 2560, 128, 4, (bf16_t*)(ws + OFF_VT));
}

template <int DQK, bool WIN>
__device__ __forceinline__ void attn_phase(LAS unsigned char* lds, const bf16_t* __restrict__ Q, int ldq, const bf16_t* __restrict__ K, int ldk,
                                           const bf16_t* __restrict__ VT, bf16_t* __restrict__ O, int HQ, int HK, const float* __restrict__ sink, float cscale) {
    constexpr int KS = DQK * 2 + 16, VS = 144, KB = 64 * KS, VB = 128 * VS, BUF = KB + VB, NKS = DQK / 16, KCH = DQK / 8, NKL = 64 * KCH / 512;
    static_assert(3 * BUF <= LDS_STAGE, "lds");
    const int tid = tid_opaque(), lane = tid & 63, wave = __builtin_amdgcn_readfirstlane(tid >> 6), l31 = lane & 31, hh = lane >> 5;
    const bool grpB = wave >= 4;
    const int pi = (l31 & 0x13) | ((l31 & 4) << 1) | ((l31 & 8) >> 1);
    const int G = HQ / HK, nitems = SPC * HQ * 16;
    const int G_ = gridDim.x, b_ = blockIdx.x, vb = (G_ & 7) == 0 ? (b_ & 7) * (G_ >> 3) + (b_ >> 3) : b_;
    for (int it = vb; it < nitems; it += gridDim.x) {
        const int qb = it & 15, head = (it >> 4) % HQ, seq = it / (16 * HQ), hk = head / G;
        const int q0 = qb * 256, wq0 = q0 + wave * 32, qrow = wq0 + l31;
        bf16x8 qf[NKS];
        { const bf16_t __attribute__((address_space(1)))* qp = (const bf16_t __attribute__((address_space(1)))*)Q + (size_t)(seq * SEQ + qrow) * ldq + head * DQK + hh * 8;
#pragma unroll
          for (int ks = 0; ks < NKS; ++ks) qf[ks] = *(const bf16x8 __attribute__((address_space(1)))*)(qp + ks * 16); }
        int kt_lo = 0, kt_hi = SEQ / 64;
        if (WIN) { kt_lo = (q0 - 128 > 0 ? q0 - 128 : 0) >> 6; kt_hi = (q0 + 384 < SEQ ? q0 + 384 : SEQ) >> 6; }
        const bf16_t __attribute__((address_space(1)))* kbase = (const bf16_t __attribute__((address_space(1)))*)K + (size_t)(seq * SEQ) * ldk + hk * DQK;
        const bf16_t __attribute__((address_space(1)))* vbase = (const bf16_t __attribute__((address_space(1)))*)VT + (size_t)((seq * HK + hk) * 128) * SEQ;
        f32x16 o[4];
#pragma unroll
        for (int db = 0; db < 4; ++db)
#pragma unroll
            for (int i = 0; i < 16; ++i) o[db][i] = 0.f;
        float m = WIN ? sink[head] * LOG2E / cscale : -1e30f;
        float lsum = (WIN && hh == 0) ? 1.f : 0.f;
        u32x4 kreg[NKL], vreg[2];
        unsigned koff[NKL], voff[2];
#pragma unroll
        for (int i_ = 0; i_ < NKL; ++i_) { const int ch_ = tid + 512 * i_, row_ = ch_ / KCH, cc_ = ch_ % KCH; koff[i_] = (unsigned)(row_ * ldk + cc_ * 8) * 2u; }
#pragma unroll
        for (int i_ = 0; i_ < 2; ++i_) { const int ch_ = tid + 512 * i_, row_ = ch_ >> 3, cc_ = ch_ & 7; voff[i_] = (unsigned)(row_ * SEQ + cc_ * 8) * 2u; }
#define ATT_GLOAD(kt_) do { \
            const char __attribute__((address_space(1)))* kt_b = (const char __attribute__((address_space(1)))*)kbase + (size_t)(kt_) * 64 * ldk * 2; \
            const char __attribute__((address_space(1)))* vt_b = (const char __attribute__((address_space(1)))*)vbase + (size_t)(kt_) * 128; \
            _Pragma("unroll") for (int i_ = 0; i_ < NKL; ++i_) kreg[i_] = *(const u32x4 __attribute__((address_space(1)))*)(kt_b + koff[i_]); \
            _Pragma("unroll") for (int i_ = 0; i_ < 2; ++i_) vreg[i_] = *(const u32x4 __attribute__((address_space(1)))*)(vt_b + voff[i_]); } while (0)
#define ATT_LSTORE(b_) do { \
            _Pragma("unroll") for (int i_ = 0; i_ < NKL; ++i_) { const int ch_ = tid + 512 * i_, row_ = ch_ / KCH, cc_ = ch_ % KCH; *(LAS u32x4*)(lds + (b_) * BUF + row_ * KS + cc_ * 16) = kreg[i_]; } \
            _Pragma("unroll") for (int i_ = 0; i_ < 2; ++i_) { const int ch_ = tid + 512 * i_, row_ = ch_ >> 3, cc_ = ch_ & 7; *(LAS u32x4*)(lds + (b_) * BUF + KB + row_ * VS + cc_ * 16) = vreg[i_]; } } while (0)
        ATT_GLOAD(kt_lo); ATT_LSTORE(0); __syncthreads();
        for (int kt = kt_lo; kt < kt_hi; ++kt) {
            const int cur = (kt - kt_lo) & 1;
            const bool more = kt + 1 < kt_hi;
            if (more) ATT_GLOAD(kt + 1);
            bool need = true;
            if (WIN) need = (kt * 64 + 63 >= wq0 - 128) && (kt * 64 <= wq0 + 31 + 128);
            if (need) {
                LAS unsigned char* kb_ = lds + cur * BUF; LAS unsigned char* vb_ = kb_ + KB;
                f32x16 s[2];
#pragma unroll
                for (int kb2 = 0; kb2 < 2; ++kb2)
#pragma unroll
                    for (int i = 0; i < 16; ++i) s[kb2][i] = 0.f;
                constexpr int KG = DQK == 128 ? 4 : 2;
#pragma unroll
                for (int g4 = 0; g4 < NKS / KG; ++g4) {
                    bf16x8 ka[2][KG];
#pragma unroll
                    for (int k = 0; k < KG; ++k)
#pragma unroll
                        for (int kb2 = 0; kb2 < 2; ++kb2) ka[kb2][k] = *(const LAS bf16x8*)(kb_ + (kb2 * 32 + pi) * KS + (g4 * KG + k) * 32 + hh * 16);
                    __builtin_amdgcn_sched_barrier(0);
#pragma unroll
                    for (int k = 0; k < KG; ++k)
#pragma unroll
                        for (int kb2 = 0; kb2 < 2; ++kb2) s[kb2] = __builtin_amdgcn_mfma_f32_32x32x16_bf16(ka[kb2][k], qf[g4 * KG + k], s[kb2], 0, 0, 0);
                    __builtin_amdgcn_sched_barrier(0);
                }
                float mx = -1e30f;
#pragma unroll
                for (int kb2 = 0; kb2 < 2; ++kb2)
#pragma unroll
                    for (int ii = 0; ii < 16; ++ii) { float t = s[kb2][ii];
                        if (WIN) { const int kp = kt * 64 + kb2 * 32 + 16 * (ii >> 3) + 8 * hh + (ii & 7); const int d = qrow - kp; t = (d <= 128 && d >= -128) ? t : -1e30f; s[kb2][ii] = t; }
                        mx = fmaxf(mx, t); }
                mx = fmaxf(mx, shflx(mx, lane, 32));
                const bool moved = __builtin_amdgcn_ballot_w64((mx - m) * cscale > 8.0f) != 0ull;
                const float mn = moved ? fmaxf(m, mx) : m;
                const float mnc = -mn * cscale;
                if (moved) { const float alpha = __builtin_amdgcn_exp2f((m - mn) * cscale); m = mn; lsum *= alpha;
#pragma unroll
                    for (int db = 0; db < 4; ++db)
#pragma unroll
                        for (int i = 0; i < 16; ++i) o[db][i] *= alpha; }
                float ps = 0.f;
#define ATT_P8(j_) do { const int kb_p = (j_) >> 1, b_p = ((j_) & 1) * 8; \
                    _Pragma("unroll") for (int e_ = 0; e_ < 8; ++e_) { const float pv = __builtin_amdgcn_exp2f(fmaf(s[kb_p][b_p + e_], cscale, mnc)); s[kb_p][b_p + e_] = pv; ps += pv; } } while (0)
                ATT_P8(0);
#pragma unroll
                for (int j = 0; j < 4; ++j) { const int kb2 = j >> 1, b8 = (j & 1) * 8; __builtin_amdgcn_sched_barrier(0);
                    bf16x8 va[4];
#pragma unroll
                    for (int db = 0; db < 4; ++db) va[db] = *(const LAS bf16x8*)(vb_ + (db * 32 + l31) * VS + (16 * j + 8 * hh) * 2);
                    u32x4 pb = {pk2(s[kb2][b8], s[kb2][b8 + 1]), pk2(s[kb2][b8 + 2], s[kb2][b8 + 3]), pk2(s[kb2][b8 + 4], s[kb2][b8 + 5]), pk2(s[kb2][b8 + 6], s[kb2][b8 + 7])};
                    const bf16x8 bfrag = __builtin_bit_cast(bf16x8, pb);
                    __builtin_amdgcn_sched_barrier(0);
#pragma unroll
                    for (int db = 0; db < 4; ++db) o[db] = __builtin_amdgcn_mfma_f32_32x32x16_bf16(va[db], bfrag, o[db], 0, 0, 0);
                    if (j < 3) ATT_P8(j + 1); }
#undef ATT_P8
                lsum += ps;
            }
            if (more) ATT_LSTORE(cur ^ 1);
            __syncthreads();
        }
#undef ATT_GLOAD
#undef ATT_LSTORE
        const float l = lsum + shflx(lsum, lane, 32); const float inv = 1.0f / l;
        bf16_t __attribute__((address_space(1)))* op = (bf16_t __attribute__((address_space(1)))*)O + (size_t)(seq * SEQ + qrow) * DM + head * 128 + 4 * hh;
#pragma unroll
        for (int db = 0; db < 4; ++db)
#pragma unroll
            for (int g = 0; g < 4; ++g) { u32x2 w = {pk2(o[db][4 * g] * inv, o[db][4 * g + 1] * inv), pk2(o[db][4 * g + 2] * inv, o[db][4 * g + 3] * inv)};
                *(u32x2 __attribute__((address_space(1)))*)(op + db * 32 + 8 * g) = w; }
    }
}

#define XB_TMO      128
#define XB_XCNT(j)  (256  + 64 * (j))
#define XB_XSUB(j)  (1280 + 64 * (j))
#define XB_XGEN(j)  (2304 + 64 * (j))
#define XB_TOP      3328
#define XB_TOPGEN   3392
#define XCD_BAR_WORDS 3456
#define XB_SPIN_CAP (1u << 18)

__device__ __forceinline__ unsigned xb_ld(unsigned* p)              { return __hip_atomic_load(p, __ATOMIC_RELAXED, __HIP_MEMORY_SCOPE_AGENT); }
__device__ __forceinline__ unsigned xb_add(unsigned* p, unsigned v) { return __hip_atomic_fetch_add(p, v, __ATOMIC_RELAXED, __HIP_MEMORY_SCOPE_AGENT); }
__device__ __forceinline__ unsigned xb_xcc_id() { return (unsigned)__builtin_amdgcn_s_getreg((3 << 11) | 20) & 0xFu; }
#define XB_SPIN(cond, bar) do { unsigned _sp = 0; while (cond) { __builtin_amdgcn_s_sleep(1); \
    if ((++_sp & 255u) == 0u) { if (xb_ld(&(bar)[XB_TMO])) break; if (_sp > XB_SPIN_CAP) { atomicAdd(&(bar)[XB_TMO], 1u); break; } } } } while (0)

struct XcdBarrier {
    unsigned* bar; unsigned x;
    volatile LAS unsigned* st;
};

__device__ __forceinline__ XcdBarrier xcd_barrier_post(unsigned* bar, volatile LAS unsigned* st) {
    XcdBarrier b; b.bar = bar; b.x = xb_xcc_id(); b.st = st;
    if (threadIdx.x == 0) (void)xb_add(&bar[XB_XCNT(b.x)], 1u);
    return b;
}
__device__ __forceinline__ void xcd_barrier_complete(unsigned* bar, unsigned x, unsigned& nloc, unsigned& nx) {
    const unsigned G = gridDim.x * gridDim.y * gridDim.z;
    unsigned sum, cnt, mine, sp = 0u;
    for (;;) {
        sum = 0u; cnt = 0u; mine = 0u;
#pragma unroll
        for (unsigned j = 0; j < 16; ++j) { const unsigned c = xb_ld(&bar[XB_XCNT(j)]); sum += c; cnt += (c > 0u) ? 1u : 0u; mine = (j == x) ? c : mine; }
        if (sum == G) break;
        __builtin_amdgcn_s_sleep(1);
        if ((++sp & 255u) == 0u) { if (xb_ld(&bar[XB_TMO])) break; if (sp > XB_SPIN_CAP) { atomicAdd(&bar[XB_TMO], 1u); break; } }
    }
    nloc = mine > 0u ? mine : 1u; nx = cnt > 0u ? cnt : 1u;
}

__device__ __forceinline__ void xcd_barrier(const XcdBarrier& b) {
    asm volatile("s_waitcnt vmcnt(0)" ::: "memory");
    __syncthreads();
    if (threadIdx.x == 0) {
        unsigned* bar = b.bar;
        __builtin_amdgcn_s_waitcnt(0);
        unsigned nloc = b.st[0], nx = b.st[1];
        if (nloc == 0u) { xcd_barrier_complete(bar, b.x, nloc, nx); b.st[0] = nloc; b.st[1] = nx; }
        const unsigned old = xb_add(&bar[XB_XSUB(b.x)], 1u);
        const unsigned gen = old / nloc;
        if (old + 1u == (gen + 1u) * nloc) {
            __builtin_amdgcn_fence(__ATOMIC_RELEASE, "agent");
            asm volatile("s_waitcnt vmcnt(0)" ::: "memory");
            const unsigned og = xb_add(&bar[XB_TOP], 1u);
            const unsigned tg = og / nx;
            if (og + 1u == (tg + 1u) * nx) xb_add(&bar[XB_TOPGEN], 1u);
            else XB_SPIN(xb_ld(&bar[XB_TOPGEN]) == tg, bar);
            __builtin_amdgcn_fence(__ATOMIC_ACQUIRE, "agent");
            xb_add(&bar[XB_XGEN(b.x)], 1u);
            asm volatile("s_waitcnt vmcnt(0)" ::: "memory");
        } else {
            XB_SPIN(xb_ld(&bar[XB_XGEN(b.x)]) == gen, bar);
            __builtin_amdgcn_fence(__ATOMIC_ACQUIRE, "agent");
            asm volatile("s_waitcnt vmcnt(0)" ::: "memory");
        }
    }
    __syncthreads();
}


struct EpiAny {
    static constexpr bool AFTER_DRAIN = false;
    int mode; EpiStoreBf16 e0; EpiSwiglu e1; EpiResid e2; mutable float prev[8];
    __device__ __forceinline__ bool perm() const { return true; }
    __device__ __forceinline__ void pre(const pg8::Unit& u, int wr, int fr, int tid) const {
        if (mode != 2 && e0.ssq) { const float __attribute__((address_space(1)))* sp = (const float __attribute__((address_space(1)))*)e0.ssq + u.pm * 256 + wr * 64 + fr;
#pragma unroll
            for (int j = 0; j < 8; ++j) prev[j] = sp[(j >> 2) * 128 + (j & 3) * 16]; }
    }
    __device__ __forceinline__ void operator()(const f32x4 (&acc)[2][2][4][2], const pg8::Unit& u, int wr, int wc, int fr, int fq) const {
        if (mode == 0) e0(acc, u, wr, wc, fr, fq, prev); else if (mode == 1) e1(acc, u, wr, wc, fr, fq, prev); else e2(acc, u, wr, wc, fr, fq);
    }
};
constexpr int PPC = 17, NPHASE = 1 + NCH * PPC;
enum { K_GU = 0, K_DOWN, K_INPROJ, K_PREP1, K_QKVB, K_PREP2, K_ATTN, K_OUT };
__device__ __forceinline__ void run_phase(const Params& p, int ph, LAS unsigned char* lds) {
    unsigned char* ws = p.ws; OPAQUE(ws);
    const int q = ph - 1, chunk = q / PPC, r = q % PPC, layer = r >= 9, sidx = layer ? r - 9 : r;
    int kind, f = 0;
    if (sidx < 2) kind = sidx;
    else if (layer == 0) { if (sidx == 2) kind = K_INPROJ; else if (sidx < 7) kind = sidx + 1; else { kind = sidx - 7; f = 1; } }
    else { if (sidx == 2) kind = K_INPROJ; else if (sidx == 3) kind = K_PREP1; else if (sidx == 4) kind = K_ATTN; else if (sidx == 5) kind = K_OUT; else { kind = sidx - 6; f = 1; } }
    if (kind == K_PREP1) {
        for (int rep = 0; rep < REP_PREP; ++rep) gqa_prep(p, ws, lds);
        return; }
    if (kind == K_PREP2) { mla_prep2(p, ws, lds); return; }
    if (kind == K_ATTN) {
        for (int rep = 0; rep < REP_ATT; ++rep)
        if (layer == 0) attn_phase<192, false>(lds, (const bf16_t*)(ws + OFF_QR), 1536, (const bf16_t*)(ws + OFF_KF), 1536, (const bf16_t*)(ws + OFF_VT), (bf16_t*)(ws + OFF_ATT), 8, 8, nullptr, 0.07216878364870322f * LOG2E);
        else attn_phase<128, true>(lds, (const bf16_t*)(ws + OFF_KVR), 2048, (const bf16_t*)(ws + OFF_QA), 512, (const bf16_t*)(ws + OFF_VT), (bf16_t*)(ws + OFF_ATT), 16, 4, p.in[I_CSINK], 0.08838834764831845f * LOG2E);
        return; }
    const int njobs = kind == K_QKVB ? 2 : 1;
    const int nf = layer * 2 + f, slot = nf;
    for (int w = 0; w < njobs; ++w) {
        size_t offA, offB, offO = 0; int M = MC, N, K, lda = 0, mode, ldc = 0, ssq_in = -1, ssq_out = -1, row_base = chunk * MC; float scale = 1.0f, inv_n = 1.0f / DM; bool fi = false; bool sq2 = false;
        if (kind == K_GU) { offA = OFF_XB + (size_t)chunk * MC * DM * 2; offB = OFF_WGU + slot * SZ_WGU; N = 2 * DFF; K = DM; mode = 1; offO = OFF_H; ldc = DFF; ssq_in = nf == 0 ? 0 : (nf == 1 ? 2 : (nf == 2 ? 3 : 5)); }
        else if (kind == K_DOWN) { offA = OFF_H; offB = OFF_WD + slot * SZ_WD; N = DM; K = DFF; mode = 2; scale = 0.5f; fi = nf == 0; ssq_out = nf == 0 ? 1 : (nf == 1 ? 3 : (nf == 2 ? 4 : -1)); }
        else if (kind == K_INPROJ) { offA = OFF_XB + (size_t)chunk * MC * DM * 2; offB = layer ? OFF_WIN1 : OFF_WIN0; N = layer ? ZW1 : ZW0; K = DM; mode = 0; offO = OFF_Z; ldc = N; ssq_in = layer ? 4 : 1; sq2 = layer == 0; }
        else if (kind == K_QKVB) { offA = OFF_Z + (w ? 1024 : 0); lda = ZW0; offB = w ? OFF_WKVB : OFF_WQB; N = w ? 2048 : 1536; K = 512; mode = 0; offO = w ? OFF_KVR : OFF_QR; ldc = N; ssq_in = 6 + w; inv_n = 1.0f / 512.0f; }
        else { offA = OFF_ATT; offB = layer ? OFF_WOUT1 : OFF_WOUT0; N = DM; K = DM; mode = 2; ssq_out = layer ? 5 : 2; }
        if (lda == 0) lda = K;
        EpiAny E; E.mode = mode;
#pragma unroll
        for (int j = 0; j < 8; ++j) E.prev[j] = 1.0f;
        const float* ssqi = ssq_in >= 0 ? (const float*)(ws + OFF_SSQ) + (size_t)ssq_in * MTOT + row_base : nullptr;
        E.e0.O = (bf16_t*)(ws + offO); E.e0.ldc = ldc; E.e0.ssq = ssqi; E.e0.inv_n = inv_n; E.e0.sq2 = sq2 ? (float*)(ws + OFF_SSQ2) + row_base : nullptr;
        E.e1.H = (bf16_t*)(ws + offO); E.e1.ldc = ldc; E.e1.ssq = ssqi; E.e1.pad_ = 0;
        const float* xp = p.in[I_XP]; const float* xs = p.in[I_XS]; OPAQUE(xp); OPAQUE(xs);
        E.e2.dst = ssq_out >= 0 ? nullptr : p.out; E.e2.src0 = xp; E.e2.src1 = xs; E.e2.split_row = NPROMPT; E.e2.row_base = row_base; E.e2.scale = scale; E.e2.fi = (fi && !RESID_FROM_XB) ? 1 : 0;
        E.e2.xb = (bf16_t*)(ws + OFF_XB); E.e2.ssq_out = ssq_out >= 0 ? (float*)(ws + OFF_SSQ) + (size_t)ssq_out * MTOT : nullptr;
#if PREFETCH_B
        {
            const int tid_ = tid_opaque(); const u32x4* wp = (const u32x4*)(ws + offB); const int n16 = (int)(((size_t)N * K * 2) >> 4);
            unsigned acc_ = 0u;
            for (int i = blockIdx.x * NTHR + tid_; i < (n16 >> 3); i += gridDim.x * NTHR) { const u32x4 v_ = wp[(size_t)i * 8]; acc_ ^= v_[0]; }
            if (acc_ == 0x9e3779b9u && N == 7) ((unsigned*)(ws + OFF_BAR))[200] = acc_;
        }
#endif
        pg8::Gemm g; g.A = (const bf16_t*)(ws + offA); g.Bt = (const bf16_t*)(ws + offB); g.M = M; g.N = N; g.K = K; g.lda = lda;
        pg8::StaticOrder S; S.init(M, N, (int)gridDim.x, (int)blockIdx.x);
        if (mode == 2) S.wgm = WGM_RES;
        if (mode == 1) S.wgm = WGM_GU;
        pg8::gemm_phase<EpiAny, pg8::StaticOrder, false>(lds, g, S, E, nullptr);
    }
}
__global__ void __launch_bounds__(NTHR, 2) mega(Params p) {
    extern __shared__ __attribute__((aligned(16))) unsigned char smem[];
    LAS unsigned char* lds = (LAS unsigned char*)smem;
    cg::grid_group grid = cg::this_grid();
    volatile LAS unsigned* st = (volatile LAS unsigned*)(lds + LDS_STAGE);
    if (threadIdx.x < 4) st[threadIdx.x] = 0u;
    __syncthreads();
    XcdBarrier bar = xcd_barrier_post((unsigned*)(p.ws + OFF_BAR), st);
    int ph0 = p.ph_lo;
    if (ph0 == 0) {
        unsigned char* ws = p.ws; OPAQUE(ws);
        for (int rep = 0; rep < REP_INIT; ++rep) init_phase(p, lds, ws);
        if (p.ph_hi < 0) grid.sync();
        if (p.ph_hi > 1) xcd_barrier(bar);
        for (int i = 0; i < REP_SYNC; ++i) xcd_barrier(bar);
        ph0 = 1;
    }
    for (int ph = ph0; ph < p.ph_hi; ++ph) {
        run_phase(p, ph, lds);
        if (ph + 1 < p.ph_hi) xcd_barrier(bar);
    }
}

extern "C" void kernel_launch(void* const* d_in, const int* in_sizes, int n_in, void* d_out, int out_size, void* d_ws, size_t ws_size, hipStream_t stream) {
    static int grid = 0;
    if (grid == 0) {
        if (n_in != 21 || ws_size < WS_END || out_size != MTOT * DM) { fprintf(stderr, "kernel_launch: unexpected shapes (n_in %d, ws %zu need %zu, out %d)\n", n_in, ws_size, (size_t)WS_END, out_size); grid = -1; return; }
        int dev = 0, cus = 0, per_cu = 0;
        hipGetDevice(&dev);
        hipDeviceGetAttribute(&cus, hipDeviceAttributeMultiprocessorCount, dev);
        if (hipFuncSetAttribute((const void*)mega, hipFuncAttributeMaxDynamicSharedMemorySize, LDS_BYTES) != hipSuccess) { fprintf(stderr, "kernel_launch: hipFuncSetAttribute failed\n"); grid = -1; return; }
        if (hipOccupancyMaxActiveBlocksPerMultiprocessor(&per_cu, (const void*)mega, NTHR, LDS_BYTES) != hipSuccess || per_cu < 1) { fprintf(stderr, "kernel_launch: occupancy query says %d\n", per_cu); per_cu = 1; }
        (void)hipGetLastError();
        grid = cus * per_cu;
    }
    if (grid < 0) return;
    Params p{};
    for (int i = 0; i < 21; ++i) p.in[i] = (const float*)d_in[i];
    p.out = (float*)d_out; p.ws = (unsigned char*)d_ws;
#if ONE_LAUNCH
    if (hipMemsetAsync((unsigned char*)d_ws + OFF_BAR, 0, BAR_BYTES, stream) != hipSuccess) fprintf(stderr, "kernel_launch: memset failed\n");
    p.ph_lo = 0; p.ph_hi = NPHASE;
    void* args[] = {&p};
    hipError_t e = hipLaunchCooperativeKernel((const void*)mega, dim3(grid), dim3(NTHR), args, LDS_BYTES, stream);
    if (e != hipSuccess) fprintf(stderr, "kernel_launch: cooperative launch failed: %s (grid %d)\n", hipGetErrorString(e), grid);
#else
    for (int ph = 0; ph < NPHASE; ++ph) {
        p.ph_lo = ph; p.ph_hi = ph + 1;
        hipLaunchKernelGGL(mega, dim3(grid), dim3(NTHR), LDS_BYTES, stream, p);
    }
#endif
}
```
